# Optimizing an MI355X kernel written in HIP

```python
import numpy as np
import jax
import jax.numpy as jnp
from jax import lax

D_MODEL = 2048
BATCH = 1
SEQ = 8192
DEPTH = 1

A_HEADS = 12
A_HEAD_DIM = 128
A_WIDTH = A_HEADS * A_HEAD_DIM
A_SCALE = A_HEAD_DIM ** -0.5
DILATED_CONFIGS = ((128, 1), (512, 4), (2048, 16))
B_HEADS = 8
B_KEY_DIM = 128
B_VAL_DIM = 128
B_WIDTH = B_HEADS * B_KEY_DIM
B_CHUNK = 64
N_GROUPS = 4
EXPERTS_PER_GROUP = 8
EXPERT_FF = 512
TOP_K_IN_GROUP = 2
NORM_EPS = 1e-6
IN_SPLITS = (A_WIDTH, A_WIDTH, A_WIDTH, B_WIDTH, B_WIDTH, B_WIDTH, B_WIDTH, D_MODEL, D_MODEL)
IN_WIDTH = A_WIDTH * 3 + B_WIDTH * 4 + D_MODEL * 2

kernel_name = 'hybrid_dilated_attn_hgrn2_hmoe'


def rms_norm(x, g):
    xf = x.astype(jnp.float32)
    xf = xf * lax.rsqrt(jnp.mean(xf * xf, axis=-1, keepdims=True) + NORM_EPS)
    return xf * g.astype(jnp.float32)


def dilated_window_attention(q, k, v, window, dilation):
    b, s, h, dh = q.shape
    blk = window // dilation
    m = s // dilation
    nb = -(-m // blk)
    mp = nb * blk

    def to_sub(t):
        t = t.reshape(b, m, dilation, h, dh).transpose(0, 2, 3, 1, 4)
        return jnp.pad(t, ((0, 0), (0, 0), (0, 0), (0, mp - m), (0, 0)))

    def kv_blocks(t):
        tp = jnp.pad(t, ((0, 0), (0, 0), (0, 0), (blk, 0), (0, 0)))
        prev = tp[:, :, :, :mp].reshape(b, dilation, h, nb, blk, dh)
        cur = tp[:, :, :, blk:].reshape(b, dilation, h, nb, blk, dh)
        return jnp.concatenate([prev, cur], axis=4)

    qb = to_sub(q).reshape(b, dilation, h, nb, blk, dh)
    kb = kv_blocks(to_sub(k))
    vb = kv_blocks(to_sub(v))
    qi = jnp.arange(blk)[:, None]
    kj = jnp.arange(2 * blk)[None, :]
    dist = qi - kj + blk
    key_pos = jnp.arange(nb)[:, None, None] * blk - blk + kj[None]
    mask = (dist >= 0)[None] & (dist <= blk)[None] & (key_pos >= 0)
    scores = jnp.einsum('bdhnqe,bdhnke->bdhnqk', qb, kb) * A_SCALE
    scores = jnp.where(mask, scores, -jnp.inf)
    mx = jnp.max(scores, axis=-1, keepdims=True)
    p = jnp.exp(scores - mx)
    den = jnp.sum(p, axis=-1, keepdims=True)
    o = jnp.einsum('bdhnqk,bdhnke->bdhnqe', p, vb) / den
    lse = (mx + jnp.log(den))[..., 0]
    o = o.reshape(b, dilation, h, mp, dh)[:, :, :, :m].transpose(0, 3, 1, 2, 4).reshape(b, s, h, dh)
    lse = lse.reshape(b, dilation, h, mp)[:, :, :, :m].transpose(0, 3, 1, 2).reshape(b, s, h)
    return o, lse


def hgrn2_chunked(q, log_f, k, v):
    b, s, h, dk = q.shape
    dv = v.shape[-1]
    nc = s // B_CHUNK

    def chunks(t):
        return t.reshape(b, nc, B_CHUNK, h, t.shape[-1]).transpose(1, 0, 3, 2, 4)

    causal = jnp.tril(jnp.ones((B_CHUNK, B_CHUNK), dtype=bool))

    def step(state, inp):
        qc, lfc, kc, vc = inp
        bc = jnp.cumsum(lfc, axis=2)
        rel = bc[:, :, :, None, :] - bc[:, :, None, :, :]
        decay = jnp.exp(jnp.where(causal[:, :, None], rel, -jnp.inf))
        attn = jnp.einsum('bhtk,bhsk,bhtsk->bhts', qc, kc, decay)
        o = (jnp.einsum('bhts,bhsv->bhtv', attn, vc)
             + jnp.einsum('bhtk,bhkv->bhtv', qc * jnp.exp(bc), state))
        b_last = bc[:, :, -1:, :]
        state = (jnp.exp(b_last[:, :, 0, :])[..., None] * state
                 + jnp.einsum('bhsk,bhsv->bhkv', kc * jnp.exp(b_last - bc), vc))
        return state, o

    s0 = jnp.zeros((b, h, dk, dv), jnp.float32)
    _, o = lax.scan(step, s0, (chunks(q), chunks(log_f), chunks(k), chunks(v)))
    return o.transpose(1, 0, 3, 2, 4).reshape(b, s, h, dv)


def hierarchical_moe(xn, rwg, rbg, rwe, rbe, w1, w3, w2):
    b, s, d = xn.shape
    xf = xn.reshape(b * s, d)
    lg = (xf @ rwg).astype(jnp.float32) + rbg.astype(jnp.float32)
    pg = jax.nn.softmax(lg, axis=-1)
    g_idx = jnp.argmax(lg, axis=-1)
    pg_top = jnp.take_along_axis(pg, g_idx[:, None], axis=1)
    le = ((xf @ rwe).astype(jnp.float32) + rbe.astype(jnp.float32)).reshape(-1, N_GROUPS, EXPERTS_PER_GROUP)
    le_sel = jnp.take_along_axis(le, g_idx[:, None, None], axis=1)[:, 0]
    top_vals, top_idx = lax.top_k(le_sel, TOP_K_IN_GROUP)
    wk = jax.nn.softmax(top_vals, axis=-1) * pg_top
    within = jnp.einsum('tk,tke->te', wk, jax.nn.one_hot(top_idx, EXPERTS_PER_GROUP, dtype=jnp.float32))
    comb = jax.nn.one_hot(g_idx, N_GROUPS, dtype=jnp.float32)[:, :, None] * within[:, None, :]
    y = jnp.zeros((b * s, d), jnp.float32)
    for gi in range(N_GROUPS):
        hid = jax.nn.silu(jnp.einsum('td,edf->tef', xf, w1[gi])) * jnp.einsum('td,edf->tef', xf, w3[gi])
        y = y + jnp.einsum('tef,efd->td', hid * comb[:, gi, :, None], w2[gi])
    return y.reshape(b, s, d)


def setup_inputs(seed: int = 0) -> dict:
    key = jax.random.key(seed)
    ks = jax.random.split(key, 20)
    f32 = jnp.float32
    def nrm(k, shape, fan_in):
        return jax.random.normal(k, shape, f32) * (fan_in ** -0.5)
    E = N_GROUPS * EXPERTS_PER_GROUP
    return {
        'x': jax.random.normal(ks[0], (BATCH, SEQ, D_MODEL), f32),
        'mix_norm_g': 1.0 + 0.1 * jax.random.normal(ks[1], (DEPTH, D_MODEL), f32),
        'w_in': nrm(ks[2], (DEPTH, D_MODEL, IN_WIDTH), D_MODEL),
        'hgrn_lb_logits': jax.random.normal(ks[3], (DEPTH + 1, B_WIDTH), f32),
        'hgrn_norm_g': 1.0 + 0.1 * jax.random.normal(ks[4], (DEPTH, B_WIDTH), f32),
        'w_branch_a': nrm(ks[5], (DEPTH, A_WIDTH, D_MODEL), A_WIDTH),
        'w_branch_b': nrm(ks[6], (DEPTH, B_WIDTH, D_MODEL), B_WIDTH),
        'w_out': nrm(ks[7], (DEPTH, D_MODEL, D_MODEL), D_MODEL),
        'ffn_norm_g': 1.0 + 0.1 * jax.random.normal(ks[8], (DEPTH, D_MODEL), f32),
        'router_w_group': nrm(ks[9], (DEPTH, D_MODEL, N_GROUPS), D_MODEL),
        'router_b_group': 0.01 * jax.random.normal(ks[10], (DEPTH, N_GROUPS), f32),
        'router_w_expert': nrm(ks[11], (DEPTH, D_MODEL, E), D_MODEL),
        'router_b_expert': 0.01 * jax.random.normal(ks[12], (DEPTH, E), f32),
        'expert_w1': nrm(ks[13], (DEPTH, N_GROUPS, EXPERTS_PER_GROUP, D_MODEL, EXPERT_FF), D_MODEL),
        'expert_w3': nrm(ks[14], (DEPTH, N_GROUPS, EXPERTS_PER_GROUP, D_MODEL, EXPERT_FF), D_MODEL),
        'expert_w2': nrm(ks[15], (DEPTH, N_GROUPS, EXPERTS_PER_GROUP, EXPERT_FF, D_MODEL), EXPERT_FF),
        'final_norm_g': 1.0 + 0.1 * jax.random.normal(ks[16], (D_MODEL,), f32),
    }


def reference(x, mix_norm_g, w_in, hgrn_lb_logits, hgrn_norm_g, w_branch_a, w_branch_b, w_out,
              ffn_norm_g, router_w_group, router_b_group, router_w_expert, router_b_expert,
              expert_w1, expert_w3, expert_w2, final_norm_g):
    b, s, _ = x.shape
    f32 = jnp.float32
    h = x.astype(f32)
    offsets = np.cumsum(IN_SPLITS)[:-1].tolist()
    lb_all = jnp.cumsum(jax.nn.softmax(hgrn_lb_logits.astype(f32), axis=0), axis=0)
    for l in range(DEPTH):
        xn = rms_norm(h, mix_norm_g[l])
        proj = (xn @ w_in[l].astype(f32))
        qa, ka, va, qb, fb, ib, gb, gate_a, gate_b = jnp.split(proj, offsets, axis=-1)
        qa = qa.reshape(b, s, A_HEADS, A_HEAD_DIM)
        ka = ka.reshape(b, s, A_HEADS, A_HEAD_DIM)
        va = va.reshape(b, s, A_HEADS, A_HEAD_DIM)
        outs, lses = [], []
        for window, dilation in DILATED_CONFIGS:
            o_c, lse_c = dilated_window_attention(qa, ka, va, window, dilation)
            outs.append(o_c)
            lses.append(lse_c)
        mix_w = jax.nn.softmax(jnp.stack(lses, axis=0), axis=0)
        oa = jnp.einsum('cbsh,cbshe->bshe', mix_w, jnp.stack(outs, axis=0)).reshape(b, s, A_WIDTH)
        ya = oa @ w_branch_a[l].astype(f32)
        lb = lb_all[l]
        f = lb + (1.0 - lb) * jax.nn.sigmoid(fb)
        q_h = jax.nn.silu(qb).reshape(b, s, B_HEADS, B_KEY_DIM)
        logf_h = jnp.log(f).reshape(b, s, B_HEADS, B_KEY_DIM)
        k_h = (1.0 - f).reshape(b, s, B_HEADS, B_KEY_DIM)
        v_h = ib.reshape(b, s, B_HEADS, B_VAL_DIM)
        ob = hgrn2_chunked(q_h, logf_h, k_h, v_h)
        ob = ob * lax.rsqrt(jnp.mean(ob * ob, axis=-1, keepdims=True) + NORM_EPS)
        ob = ob.reshape(b, s, B_WIDTH) * hgrn_norm_g[l].astype(f32) * jax.nn.silu(gb)
        yb = ob @ w_branch_b[l].astype(f32)
        merged = jax.nn.sigmoid(gate_a) * ya + jax.nn.sigmoid(gate_b) * yb
        h = h + merged @ w_out[l].astype(f32)
        hn = rms_norm(h, ffn_norm_g[l])
        h = h + hierarchical_moe(hn, router_w_group[l].astype(f32), router_b_group[l], router_w_expert[l].astype(f32),
                                 router_b_expert[l], expert_w1[l].astype(f32), expert_w3[l].astype(f32),
                                 expert_w2[l].astype(f32))
    out = rms_norm(h, final_norm_g)
    return out.astype(x.dtype)
```

```cpp
#include <hip/hip_runtime.h>
#include <cstdio>
#include <cstdint>

#ifndef MK_PER_PHASE
#define MK_PER_PHASE 0
#endif
#ifndef PROBE_REPEAT
#define PROBE_REPEAT -1
#endif

#define LAS __attribute__((address_space(3)))
#define GAS __attribute__((address_space(1)))
typedef unsigned short bf16_t;
typedef short bf16x8 __attribute__((ext_vector_type(8)));
typedef short s16x4 __attribute__((ext_vector_type(4)));
typedef float f32x4 __attribute__((ext_vector_type(4)));
typedef float f32x2 __attribute__((ext_vector_type(2)));
typedef unsigned u32x4 __attribute__((ext_vector_type(4)));
typedef unsigned u32x2 __attribute__((ext_vector_type(2)));

constexpr int T = 8192, D = 2048, NIN = 12800;
constexpr int AH = 12, AW = 1536;
constexpr int BH = 8, BW = 1024, NCH = 128;
constexpr int NE = 32, FF = 512, CAP = 8192;
constexpr float EPS = 1e-6f;
constexpr float LOG2E = 1.4426950408889634f, LN2 = 0.6931471805599453f;
constexpr float QSCALE = 0.08838834764831845f * 1.4426950408889634f;

constexpr size_t MiB = 1u << 20;
constexpr size_t WS_CTL = 0, CTL_ZERO_BYTES = 1 * MiB;
constexpr size_t WS_WIN = 1 * MiB;
constexpr size_t WS_O1 = WS_WIN, WS_O4 = WS_WIN + 24 * MiB;
constexpr size_t WS_WA = 51 * MiB;
constexpr size_t WS_WB = 57 * MiB;
constexpr size_t WS_WOUT = 61 * MiB;
constexpr size_t WS_XN = 69 * MiB;
constexpr size_t WS_QA = 101 * MiB, WS_KA = 125 * MiB, WS_VA = 149 * MiB;
constexpr size_t WS_W2 = WS_QA;
constexpr size_t WS_QB = 173 * MiB;
constexpr size_t WS_LOGF = 189 * MiB;
constexpr size_t WS_HM = 173 * MiB;
constexpr size_t WS_IB = 221 * MiB;
constexpr size_t WS_GB = 237 * MiB;
constexpr size_t WS_GA = 253 * MiB;
constexpr size_t WS_GBT = 285 * MiB;
constexpr size_t WS_ST = 317 * MiB;
constexpr size_t WS_MERGED = WS_ST, WS_YS = WS_ST;
constexpr size_t WS_OA = 381 * MiB;
constexpr size_t WS_HID = WS_OA;
constexpr size_t WS_OB = 405 * MiB;
constexpr size_t WS_W13 = 421 * MiB;
constexpr size_t WS_DEC = 549 * MiB;
constexpr size_t WS_LSE1 = WS_DEC + 512 * 1024, WS_LSE4 = WS_LSE1 + 384 * 1024;
constexpr size_t WS_RSTD = WS_LSE4 + 384 * 1024;
constexpr size_t WS_TOKL = 550 * MiB + 512 * 1024;
constexpr size_t WS_TOKW = WS_TOKL + 1 * MiB;
constexpr size_t WS_WTR = WS_TOKW + 1 * MiB;
constexpr size_t WS_SP = WS_WTR + 512 * 1024;
constexpr size_t WS_SW = WS_SP + 64 * 1024;
constexpr size_t WS_END = 554 * MiB;
constexpr int CW_BAR = 4096;
constexpr int CW_CNT = 16384;
constexpr int CW_Q1 = 24576;

constexpr int RING_BYTES = 147456;
constexpr int MISC_OFF = RING_BYTES;
constexpr int LDS_BYTES = RING_BYTES + 4096;

typedef __bf16 bf16x2_t __attribute__((ext_vector_type(2)));
__device__ __forceinline__ unsigned cvt_pk_bf16(float lo, float hi) { bf16x2_t v; v[0] = (__bf16)lo; v[1] = (__bf16)hi; return __builtin_bit_cast(unsigned, v); }
__device__ __forceinline__ float bf_lo(unsigned w) { return __uint_as_float(w << 16); }
__device__ __forceinline__ float bf_hi(unsigned w) { return __uint_as_float(w & 0xffff0000u); }
__device__ __forceinline__ float ex2(float x) { return __builtin_amdgcn_exp2f(x); }
__device__ __forceinline__ float expn(float x) { return __builtin_amdgcn_exp2f(x * LOG2E); }
__device__ __forceinline__ float lg2(float x) { return __builtin_amdgcn_logf(x); }
__device__ __forceinline__ float sigm(float x) { return __builtin_amdgcn_rcpf(1.0f + __builtin_amdgcn_exp2f(-x * LOG2E)); }
__device__ __forceinline__ float wave_sum(float v) {
#pragma unroll
    for (int o = 1; o < 64; o <<= 1) v += __shfl_xor(v, o);
    return v;
}
#define LDS_WAIT() asm volatile("s_waitcnt lgkmcnt(0)" ::: "memory")
#define VM_WAIT() asm volatile("s_waitcnt vmcnt(0)" ::: "memory")

#define XB_TMO      128
#define XB_XCNT(j)  (256  + 64 * (j))
#define XB_XSUB(j)  (1280 + 64 * (j))
#define XB_XGEN(j)  (2304 + 64 * (j))
#define XB_TOP      3328
#define XB_TOPGEN   3392
#define XCD_BAR_WORDS 3456
#define XB_SPIN_CAP (1u << 18)
__device__ __forceinline__ unsigned xb_ld(unsigned* p)              { return __hip_atomic_load(p, __ATOMIC_RELAXED, __HIP_MEMORY_SCOPE_AGENT); }
__device__ __forceinline__ unsigned xb_add(unsigned* p, unsigned v) { return __hip_atomic_fetch_add(p, v, __ATOMIC_RELAXED, __HIP_MEMORY_SCOPE_AGENT); }
__device__ __forceinline__ unsigned xb_xcc_id() { return (unsigned)__builtin_amdgcn_s_getreg((3 << 11) | 20) & 0xFu; }
#define XB_SPIN(cond, bar) do { unsigned _sp = 0; while (cond) { __builtin_amdgcn_s_sleep(1); \
    if ((++_sp & 255u) == 0u) { if (xb_ld(&(bar)[XB_TMO])) break; if (_sp > XB_SPIN_CAP) { atomicAdd(&(bar)[XB_TMO], 1u); break; } } } } while (0)
struct XcdBarrier { unsigned* bar; unsigned x; volatile LAS unsigned* st; };
__device__ __forceinline__ XcdBarrier xcd_barrier_post(unsigned* bar, volatile LAS unsigned* st) {
    XcdBarrier b; b.bar = bar; b.x = xb_xcc_id(); b.st = st;
    if (threadIdx.x == 0) (void)xb_add(&bar[XB_XCNT(b.x)], 1u);
    return b;
}
__device__ __forceinline__ void xcd_barrier_complete(unsigned* bar, unsigned x, unsigned& nloc, unsigned& nx) {
    const unsigned G = gridDim.x * gridDim.y * gridDim.z;
    unsigned sum, cnt, mine, sp = 0u;
    for (;;) {
        sum = 0u; cnt = 0u; mine = 0u;
#pragma unroll
        for (unsigned j = 0; j < 16; ++j) { const unsigned c = xb_ld(&bar[XB_XCNT(j)]); sum += c; cnt += (c > 0u) ? 1u : 0u; mine = (j == x) ? c : mine; }
        if (sum == G) break;
        __builtin_amdgcn_s_sleep(1);
        if ((++sp & 255u) == 0u) { if (xb_ld(&bar[XB_TMO])) break; if (sp > XB_SPIN_CAP) { atomicAdd(&bar[XB_TMO], 1u); break; } }
    }
    nloc = mine > 0u ? mine : 1u; nx = cnt > 0u ? cnt : 1u;
}
__device__ __forceinline__ void xcd_barrier(const XcdBarrier& b) {
    asm volatile("s_waitcnt vmcnt(0)" ::: "memory");
    __syncthreads();
    if (threadIdx.x == 0) {
        unsigned* bar = b.bar;
        __builtin_amdgcn_s_waitcnt(0);
        unsigned nloc = b.st[0], nx = b.st[1];
        if (nloc == 0u) { xcd_barrier_complete(bar, b.x, nloc, nx); b.st[0] = nloc; b.st[1] = nx; }
        const unsigned old = xb_add(&bar[XB_XSUB(b.x)], 1u);
        const unsigned gen = old / nloc;
        if (old + 1u == (gen + 1u) * nloc) {
            __builtin_amdgcn_fence(__ATOMIC_RELEASE, "agent");
            asm volatile("s_waitcnt vmcnt(0)" ::: "memory");
            const unsigned og = xb_add(&bar[XB_TOP], 1u);
            const unsigned tg = og / nx;
            if (og + 1u == (tg + 1u) * nx) xb_add(&bar[XB_TOPGEN], 1u);
            else XB_SPIN(xb_ld(&bar[XB_TOPGEN]) == tg, bar);
            __builtin_amdgcn_fence(__ATOMIC_ACQUIRE, "agent");
            xb_add(&bar[XB_XGEN(b.x)], 1u);
            asm volatile("s_waitcnt vmcnt(0)" ::: "memory");
        } else {
            XB_SPIN(xb_ld(&bar[XB_XGEN(b.x)]) == gen, bar);
            __builtin_amdgcn_fence(__ATOMIC_ACQUIRE, "agent");
            asm volatile("s_waitcnt vmcnt(0)" ::: "memory");
        }
    }
    __syncthreads();
}

namespace pg8 {
constexpr int BM = 256, BK = 64, HALF = 128, HTB = HALF * BK * 2, STAGE_BYTES = 8 * HTB, NXCD = 8, WGM = 8;
__host__ __device__ __forceinline__ int lds_byte(int r, int c) { const int st = (r >> 4) * 2 + (c >> 5), rr = r & 15, cc = c & 31, ob = rr * 64 + cc * 2; return st * 1024 + (ob ^ (((ob >> 9) & 1) << 5)); }
__host__ __device__ __forceinline__ void stage_rc(int b, int& R, int& C) { const int st = b / 1024, sb = b % 1024, swz = sb ^ (((sb >> 9) & 1) << 5); R = (st >> 1) * 16 + swz / 64; C = (st & 1) * 32 + (swz % 64) / 2; }
__host__ __device__ __forceinline__ int perm32(int rho) { const int n = rho >> 4, i = rho & 15; return 8 * (i >> 2) + 4 * n + (i & 3); }

struct Unit { int pm, pn, aux, rows, base; };

struct StaticOrder {
    int nM, nN, nwg, G, c;
    __device__ void init(int M, int N, int G_, int c_) { nM = M / BM; nN = N / BM; nwg = nM * nN; G = G_; c = c_; }
    __device__ bool next(int i, Unit& u) const {
        const long L = (long)i * G + c; if (L >= nwg) return false;
        int wgid = (int)L; { const int q = nwg / NXCD, r = nwg % NXCD, xcd = wgid % NXCD, off = wgid / NXCD; wgid = (xcd < r ? xcd * (q + 1) : r * (q + 1) + (xcd - r) * q) + off; }
        const int nig = WGM * nN, gid = wgid / nig, fm = gid * WGM, gsz = (nM - fm) < WGM ? (nM - fm) : WGM;
        u.pm = fm + ((wgid % nig) % gsz); u.pn = (wgid % nig) / gsz; u.aux = 0; u.rows = 256; u.base = 0; return true;
    }
};

template <bool GATHER> struct Ops { const char* A; const char* B; int K; unsigned oB; unsigned oA[GATHER ? 4 : 1]; };

template <class Sched> __device__ __forceinline__ void ops_setup(const Sched& S, const Unit& u, int R0, int Rb0, int C0, Ops<Sched::GATHER>& o) {
    o.K = S.kdim(u); o.A = S.a_base(u); o.B = S.b_base(u);
    o.oB = (unsigned)(Rb0 * o.K + C0) * 2u;
    if constexpr (Sched::GATHER) {
#pragma unroll
        for (int q = 0; q < 4; ++q) o.oA[q] = S.a_row_off(u, R0 + 64 * q) + (unsigned)C0 * 2u;
    } else o.oA[0] = (unsigned)(R0 * o.K + C0) * 2u;
}
template <bool GATHER> __device__ __forceinline__ void stage_a(LAS unsigned char* dst, const Ops<GATHER>& o, int h, size_t koff) {
#pragma unroll
    for (int i = 0; i < 2; ++i) {
        const char* src;
        if constexpr (GATHER) src = o.A + koff + o.oA[h * 2 + i];
        else src = o.A + (koff + (size_t)(h * 128 + i * 64) * (size_t)o.K * 2) + o.oA[0];
        __builtin_amdgcn_global_load_lds((const unsigned*)src, (LAS unsigned*)(dst + i * 8192), 16, 0, 0);
    }
}
template <bool GATHER> __device__ __forceinline__ void stage_b(LAS unsigned char* dst, const Ops<GATHER>& o, int h, size_t koff) {
#pragma unroll
    for (int i = 0; i < 2; ++i) {
        const char* src = o.B + (koff + (size_t)(h * 128 + i * 64) * (size_t)o.K * 2) + o.oB;
        __builtin_amdgcn_global_load_lds((const unsigned*)src, (LAS unsigned*)(dst + i * 8192), 16, 0, 0);
    }
}

template <class Epi, class Sched>
__device__ __forceinline__ void gemm_phase(LAS unsigned char* lds, const Sched& S, const Epi& E) {
    constexpr bool GA_ = Sched::GATHER;
    const int tid = threadIdx.x, wid = __builtin_amdgcn_readfirstlane(tid >> 6), lane = tid & 63, wr = wid >> 2, wc = wid & 3, fr = lane & 15, fq = lane >> 4;
    int R0, C0; stage_rc(tid * 16, R0, C0);
    const int Rb0 = (R0 & ~31) + perm32(R0 & 31);
    const size_t kstep = (size_t)(BK * 2);
    const unsigned ldsw = (unsigned)wid * 1024u;
    const int aoff = lds_byte(wr * 64 + fr, fq * 8), boff = lds_byte(wc * 32 + fr, fq * 8);
#define PG8_SA(b, h) (((b) * 2 + (h)) * HTB)
#define PG8_SB(b, h) ((4 + (b) * 2 + (h)) * HTB)
#define PG8_STA(b, h, O, koff) stage_a<GA_>(lds + PG8_SA(b, h) + ldsw, O, h, koff)
#define PG8_STB(b, h, O, koff) stage_b<GA_>(lds + PG8_SB(b, h) + ldsw, O, h, koff)
#define PG8_LDA(dst, b, h) do { _Pragma("unroll") for (int m = 0; m < 4; ++m) _Pragma("unroll") for (int k = 0; k < 2; ++k) dst[m][k] = *(const LAS bf16x8*)(lds + PG8_SA(b, h) + aoff + m * 2048 + k * 1024); } while (0)
#define PG8_LDB(dst, b, h) do { _Pragma("unroll") for (int n = 0; n < 2; ++n) _Pragma("unroll") for (int k = 0; k < 2; ++k) dst[n][k] = *(const LAS bf16x8*)(lds + PG8_SB(b, h) + boff + n * 2048 + k * 1024); } while (0)
#define PG8_MMA(ai, bj, At, Bt) do { __builtin_amdgcn_s_setprio(1); _Pragma("unroll") for (int m = 0; m < 4; ++m) _Pragma("unroll") for (int n = 0; n < 2; ++n) _Pragma("unroll") for (int k = 0; k < 2; ++k) \
        acc[ai][bj][m][n] = __builtin_amdgcn_mfma_f32_16x16x32_bf16(Bt[n][k], At[m][k], acc[ai][bj][m][n], 0, 0, 0); __builtin_amdgcn_s_setprio(0); } while (0)
#define PG8_WAIT_V(n) asm volatile("s_waitcnt vmcnt(" #n ")" ::: "memory")
#define PG8_WAIT_L(n) asm volatile("s_waitcnt lgkmcnt(" #n ")" ::: "memory")
#define PG8_BAR __builtin_amdgcn_s_barrier()
#define PG8_SCHED __builtin_amdgcn_sched_barrier(0)
    Unit cur, nxt; int ui = 0;
    if (!S.next(0, cur)) return;
    f32x4 acc[2][2][4][2];
#pragma unroll
    for (int a = 0; a < 2; ++a)
#pragma unroll
        for (int b = 0; b < 2; ++b)
#pragma unroll
            for (int m = 0; m < 4; ++m)
#pragma unroll
                for (int n = 0; n < 2; ++n) acc[a][b][m][n] = (f32x4){0.f, 0.f, 0.f, 0.f};
    bf16x8 At[4][2], B0[2][2], B1[2][2];
    Ops<GA_> oc, op;
    ops_setup(S, cur, R0, Rb0, C0, oc); op = oc;
    PG8_STB(0, 0, oc, 0); PG8_STB(0, 1, oc, 0); PG8_STA(0, 0, oc, 0); PG8_STA(0, 1, oc, 0);
    if (wr == 1) PG8_BAR;
    PG8_WAIT_V(2); PG8_BAR;
    PG8_STB(1, 0, oc, kstep); PG8_STA(1, 0, oc, kstep); PG8_STB(1, 1, oc, kstep);
    PG8_WAIT_V(6); PG8_BAR;
    for (;;) {
        const bool has_next = S.next(ui + 1, nxt);
        const int nt = oc.K / BK;
        const bool full = !Sched::HALFABLE || cur.rows > 128;
#define PG8_ITER(W) do { \
            const bool last = (t == nt - 2); \
            const size_t k1 = (size_t)(t + 1) * kstep; \
            if (last && has_next) ops_setup(S, nxt, R0, Rb0, C0, op); \
            const size_t k2 = last ? 0 : (size_t)(t + 2) * kstep, k3 = k2 + kstep; \
              \
            PG8_LDB(B0, 0, 0); PG8_LDB(B1, 0, 1); PG8_SCHED; PG8_LDA(At, 0, 0); PG8_STA(1, 1, oc, k1); \
            PG8_WAIT_V(W); PG8_WAIT_L(0); PG8_BAR; PG8_MMA(0, 0, At, B0); PG8_MMA(0, 1, At, B1); PG8_BAR; PG8_SCHED; \
              \
            PG8_LDA(At, 0, 1); PG8_STB(0, 0, op, k2); PG8_STB(0, 1, op, k2); PG8_STA(0, 0, op, k2); \
            PG8_WAIT_V(W); PG8_WAIT_L(0); PG8_BAR; if (full) { PG8_MMA(1, 0, At, B0); PG8_MMA(1, 1, At, B1); } PG8_BAR; PG8_SCHED; \
              \
            PG8_LDB(B0, 1, 0); PG8_LDB(B1, 1, 1); PG8_SCHED; PG8_LDA(At, 1, 0); PG8_STA(0, 1, op, k2); \
            PG8_WAIT_V(8); PG8_WAIT_L(0); PG8_BAR; PG8_MMA(0, 0, At, B0); PG8_MMA(0, 1, At, B1); PG8_BAR; PG8_SCHED; \
              \
            PG8_LDA(At, 1, 1); PG8_STB(1, 0, op, k3); PG8_STB(1, 1, op, k3); PG8_STA(1, 0, op, k3); \
            PG8_WAIT_V(8); PG8_WAIT_L(0); PG8_BAR; if (full) { PG8_MMA(1, 0, At, B0); PG8_MMA(1, 1, At, B1); } PG8_BAR; PG8_SCHED; \
        } while (0)
        int t = 0;
        if (Epi::STORES16 && ui > 0) { PG8_ITER(24); t = 2; }
        for (; t < nt; t += 2) PG8_ITER(8);
#undef PG8_ITER
        if (wr == 0) PG8_BAR;
        const bool reset = E(acc, cur, wr, wc, fr, fq);
        if (!has_next) break;
        if (reset) {
#pragma unroll
            for (int a = 0; a < 2; ++a)
#pragma unroll
                for (int b = 0; b < 2; ++b)
#pragma unroll
                    for (int m = 0; m < 4; ++m)
#pragma unroll
                        for (int n = 0; n < 2; ++n) acc[a][b][m][n] = (f32x4){0.f, 0.f, 0.f, 0.f};
        }
        cur = nxt; oc = op; ++ui;
        if (wr == 1) PG8_BAR;
    }
    PG8_WAIT_V(0);
    PG8_BAR;
#undef PG8_SA
#undef PG8_SB
#undef PG8_STA
#undef PG8_STB
#undef PG8_LDA
#undef PG8_LDB
#undef PG8_MMA
#undef PG8_WAIT_V
#undef PG8_WAIT_L
#undef PG8_BAR
#undef PG8_SCHED
}
}

struct Frame {
    LAS unsigned char* lds;
    unsigned* ctl;
    int tid, lane, wave, vcu, G;
    const float* in[17];
    float* out;
    unsigned char* ws;
};
#define WSP(type, off) ((type*)(F.ws + (off)))

constexpr int TSCR = 64 * 65 * 4;
template <bool NT> __device__ __forceinline__ void tr64_load(f32x4 (&v)[16], const float* W, int ldw, int k0, int n0, int lane, const float* gk = nullptr) {
    const int r4 = lane >> 4, c4 = lane & 15;
#pragma unroll
    for (int it = 0; it < 16; ++it) { const f32x4* src = (const f32x4*)(W + (size_t)(k0 + 4 * it + r4) * ldw + n0 + 4 * c4); v[it] = NT ? __builtin_nontemporal_load(src) : *src; }
    if (gk) { const float gl = gk[k0 + lane];
#pragma unroll
        for (int it = 0; it < 16; ++it) v[it] = v[it] * __shfl(gl, 4 * it + r4); }
}
template <bool NT> __device__ __forceinline__ void tr64_finish(const f32x4 (&v)[16], int k0, bf16_t* WT, int ldt, int drow0, LAS float* scr, int lane) {
    const int r4 = lane >> 4, c4 = lane & 15;
#pragma unroll
    for (int it = 0; it < 16; ++it) { LAS float* d = scr + (4 * it + r4) * 65 + 4 * c4; d[0] = v[it].x; d[1] = v[it].y; d[2] = v[it].z; d[3] = v[it].w; }
    LDS_WAIT(); asm volatile("" ::: "memory");
    const int c = lane & 7;
#pragma unroll
    for (int j = 0; j < 8; ++j) { const int n = (lane >> 3) + 8 * j; const LAS float* q = scr + (8 * c) * 65 + n;
        u32x4 o; o.x = cvt_pk_bf16(q[0 * 65], q[1 * 65]); o.y = cvt_pk_bf16(q[2 * 65], q[3 * 65]); o.z = cvt_pk_bf16(q[4 * 65], q[5 * 65]); o.w = cvt_pk_bf16(q[6 * 65], q[7 * 65]);
        u32x4* dst = (u32x4*)(WT + (size_t)(drow0 + n) * ldt + k0 + 8 * c); if (NT) __builtin_nontemporal_store(o, dst); else *dst = o; }
    LDS_WAIT(); asm volatile("" ::: "memory");
}
template <bool NT = false>
__device__ __forceinline__ void transpose_item64(const float* W, int ldw, int k0, int n0, bf16_t* WT, int ldt, int drow0, LAS float* scr, int lane) {
    f32x4 v[16]; tr64_load<NT>(v, W, ldw, k0, n0, lane); tr64_finish<NT>(v, k0, WT, ldt, drow0, scr, lane);
}
__device__ __forceinline__ void rms_row_to_bf16(const float* xrow, const f32x4 (&gg)[8], bf16_t* orow, int lane) {
    const f32x4* xr = (const f32x4*)xrow + lane;
    f32x4 v[8]; float s = 0.f;
#pragma unroll
    for (int j = 0; j < 8; ++j) { v[j] = xr[64 * j]; s += (v[j].x * v[j].x + v[j].y * v[j].y) + (v[j].z * v[j].z + v[j].w * v[j].w); }
    const float rstd = __builtin_amdgcn_rsqf(wave_sum(s) * (1.f / D) + EPS);
    u32x2* o8 = (u32x2*)orow + lane;
#pragma unroll
    for (int j = 0; j < 8; ++j) { u32x2 w; w.x = cvt_pk_bf16(v[j].x * rstd * gg[j].x, v[j].y * rstd * gg[j].y); w.y = cvt_pk_bf16(v[j].z * rstd * gg[j].z, v[j].w * rstd * gg[j].w); o8[64 * j] = w; }
}
constexpr int E0 = 0;
template <bool NT = false> __device__ __forceinline__ void w13_item(Frame& F, int r, LAS float* scr) {
    const int w3 = r >= 32 * 256 ? 1 : 0; if (w3) r -= 32 * 256;
    const int e = r >> 8, r2 = r & 255, kb = r2 >> 3, nb = r2 & 7, n0 = 64 * nb;
    const int drow0 = 256 * (n0 >> 7) + (n0 & 127) + 128 * w3;
    transpose_item64<NT>((w3 ? F.in[14] : F.in[13]) + (size_t)e * D * FF, FF, 64 * kb, n0, WSP(bf16_t, WS_W13) + (size_t)e * 1024 * D, D, drow0, scr, F.lane);
}
__device__ __forceinline__ void p0_prologue(Frame& F) {
    LAS float* scr = (LAS float*)(F.lds + F.wave * TSCR);
    const int gw = F.vcu * 8 + F.wave, NGW = F.G * 8;
    constexpr int I_IN = 32 * 200, I_E = E0 * 256;
    constexpr int NITEMS = I_IN + 2 * I_E;
    for (int it = gw; it < NITEMS; it += NGW) {
        int r = it;
        if (r < I_IN) { const int n0 = 64 * (r % 200); int dr = n0;
            if (n0 >= 10752) { const int gb = n0 - 10752; dr = 8704 + 256 * (gb >> 7) + 128 + (gb & 127); } else if (n0 >= 8704) { const int ga = n0 - 8704; dr = 8704 + 256 * (ga >> 7) + (ga & 127); }
            transpose_item64(F.in[2], NIN, 64 * (r / 200), n0, WSP(bf16_t, WS_WIN), D, dr, scr, F.lane); continue; } r -= I_IN;
        if (r < I_E) w13_item(F, r, scr); else w13_item(F, 32 * 256 + (r - I_E), scr);
    }
    { f32x4 gg[8];
#pragma unroll
      for (int j = 0; j < 8; ++j) gg[j] = ((const f32x4*)F.in[1])[F.lane + 64 * j];
      for (int m = gw; m < T; m += NGW) rms_row_to_bf16(F.in[0] + (size_t)m * D, gg, WSP(bf16_t, WS_XN) + (size_t)m * D, F.lane); }
    { float* wtr = WSP(float, WS_WTR);
      for (int i = F.vcu * 512 + F.tid; i < 48 * D; i += F.G * 512) { const int o = i >> 11, k = i & 2047;
          float v = 0.f; if (o < 4) v = F.in[9][k * 4 + o]; else if (o >= 16) v = F.in[11][k * 32 + (o - 16)];
          wtr[i] = v * F.in[8][k]; } }
}
constexpr int P1F_ITEMS = 24 * 32 + 16 * 32 + 32 * 32 + 2 * (32 - E0) * 256;
static_assert(E0 == 0, "w1|w3 are converted (with ffn_norm_g folded in) by the P1 queue only");
struct TrItem { const float* W; bf16_t* WT; int ldw, ldt, k0, n0, drow0; const float* gk; };
__device__ __forceinline__ TrItem p1_item(Frame& F, int r) {
    constexpr int I_A = 24 * 32, I_B = 16 * 32, I_O = 32 * 32, I_E = (32 - E0) * 256;
    if (r < I_A) return TrItem{F.in[5], WSP(bf16_t, WS_WA), D, AW, 64 * (r >> 5), 64 * (r & 31), 64 * (r & 31), nullptr}; r -= I_A;
    if (r < I_B) return TrItem{F.in[6], WSP(bf16_t, WS_WB), D, BW, 64 * (r >> 5), 64 * (r & 31), 64 * (r & 31), nullptr}; r -= I_B;
    if (r < I_O) return TrItem{F.in[7], WSP(bf16_t, WS_WOUT), D, D, 64 * (r >> 5), 64 * (r & 31), 64 * (r & 31), nullptr}; r -= I_O;
    const int w3 = r >= I_E ? 1 : 0; if (w3) r -= I_E; r += E0 * 256;
    const int e = r >> 8, r2 = r & 255, kb = r2 >> 3, nb = r2 & 7, n0 = 64 * nb;
    return TrItem{(w3 ? F.in[14] : F.in[13]) + (size_t)e * D * FF, WSP(bf16_t, WS_W13) + (size_t)e * 1024 * D, FF, D, 64 * kb, n0, 256 * (n0 >> 7) + (n0 & 127) + 128 * w3, F.in[8]};
}
__device__ __forceinline__ int q_ticket4(unsigned* q, int lane) { unsigned t = 0; if (lane == 0) t = __hip_atomic_fetch_add(q, 4u, __ATOMIC_RELAXED, __HIP_MEMORY_SCOPE_AGENT); return (int)__builtin_amdgcn_readfirstlane(t); }
__device__ __forceinline__ void p1_queue(Frame& F, int max_batches) {
    LAS float* scr = (LAS float*)(F.lds + F.wave * TSCR); unsigned* q = F.ctl + CW_Q1;
    if (max_batches <= 0) return;
    int cur = q_ticket4(q, F.lane);
    for (int nb = 0; cur < P1F_ITEMS; ++nb) { const bool lastb = (nb + 1 >= max_batches);
        const int nxt = lastb ? P1F_ITEMS : q_ticket4(q, F.lane);
        TrItem a = p1_item(F, cur), b = p1_item(F, cur + 1);
        f32x4 va[16], vb[16];
        tr64_load<true>(va, a.W, a.ldw, a.k0, a.n0, F.lane, a.gk); tr64_load<true>(vb, b.W, b.ldw, b.k0, b.n0, F.lane, b.gk);
        tr64_finish<true>(va, a.k0, a.WT, a.ldt, a.drow0, scr, F.lane);
        a = p1_item(F, cur + 2); tr64_load<true>(va, a.W, a.ldw, a.k0, a.n0, F.lane, a.gk);
        tr64_finish<true>(vb, b.k0, b.WT, b.ldt, b.drow0, scr, F.lane);
        b = p1_item(F, cur + 3); tr64_load<true>(vb, b.W, b.ldw, b.k0, b.n0, F.lane, b.gk);
        tr64_finish<true>(va, a.k0, a.WT, a.ldt, a.drow0, scr, F.lane);
        tr64_finish<true>(vb, b.k0, b.WT, b.ldt, b.drow0, scr, F.lane);
        cur = nxt;
    }
}
static_assert(P1F_ITEMS % 4 == 0, "batches of four");

__device__ __forceinline__ void dense_units(Frame& F, int M, int N, int nworkers, int widx) {
    LAS int* UD = (LAS int*)(F.lds + MISC_OFF + 1024);
    if (F.tid < 8) { pg8::StaticOrder so; so.init(M, N, nworkers, widx < 0 ? (1 << 28) : widx); pg8::Unit u; const bool ok = so.next(F.tid, u); UD[2 * F.tid] = ok ? u.pm : -1; UD[2 * F.tid + 1] = u.pn; }
    __syncthreads();
}
struct ListOrder {
    const LAS int* UD;
    __device__ __forceinline__ bool next(int i, pg8::Unit& u) const { if (i >= 8) return false; const int pm = UD[2 * i]; if (pm < 0) return false; u.pm = pm; u.pn = UD[2 * i + 1]; u.aux = 0; u.rows = 256; u.base = 0; return true; }
};
struct DenseSched {
    static constexpr bool GATHER = false, HALFABLE = false;
    const bf16_t* A; const bf16_t* Bt; int K; ListOrder so;
    __device__ __forceinline__ bool next(int i, pg8::Unit& u) const { return so.next(i, u); }
    __device__ __forceinline__ int kdim(const pg8::Unit&) const { return K; }
    __device__ __forceinline__ const char* a_base(const pg8::Unit& u) const { return (const char*)A + (size_t)u.pm * 256 * K * 2; }
    __device__ __forceinline__ const char* b_base(const pg8::Unit& u) const { return (const char*)Bt + (size_t)u.pn * 256 * K * 2; }
};
struct EpiInProj {
    static constexpr bool STORES16 = true;
    unsigned char* ws; const float* lbl; const float* hng;
    __device__ __forceinline__ bool operator()(f32x4 (&acc)[2][2][4][2], const pg8::Unit& u, int wr, int wc, int fr, int fq) const {
        const int pn = u.pn, row0 = u.pm * 256 + wr * 64 + fr, cl = wc * 32 + 8 * fq;
        if (pn >= 34) {
            bf16_t* GA = (bf16_t*)(ws + WS_GA); bf16_t* GR = (bf16_t*)(ws + WS_GBT); const int c0 = (pn - 34) * 128 + cl;
#pragma unroll
            for (int ai = 0; ai < 2; ++ai)
#pragma unroll
                for (int m = 0; m < 4; ++m) { float sa[8], rr[8];
#pragma unroll
                    for (int j = 0; j < 4; ++j) { const float ea0 = ex2(fminf(-acc[ai][0][m][0][j] * LOG2E, 60.f)), ea1 = ex2(fminf(-acc[ai][0][m][1][j] * LOG2E, 60.f)), eb0 = ex2(fminf(-acc[ai][1][m][0][j] * LOG2E, 60.f)), eb1 = ex2(fminf(-acc[ai][1][m][1][j] * LOG2E, 60.f));
                        sa[j] = __builtin_amdgcn_rcpf(1.f + ea0); sa[4 + j] = __builtin_amdgcn_rcpf(1.f + ea1);
                        rr[j] = (1.f + ea0) * __builtin_amdgcn_rcpf(1.f + eb0); rr[4 + j] = (1.f + ea1) * __builtin_amdgcn_rcpf(1.f + eb1); }
                    u32x4 w, q; w.x = cvt_pk_bf16(sa[0], sa[1]); w.y = cvt_pk_bf16(sa[2], sa[3]); w.z = cvt_pk_bf16(sa[4], sa[5]); w.w = cvt_pk_bf16(sa[6], sa[7]);
                    q.x = cvt_pk_bf16(rr[0], rr[1]); q.y = cvt_pk_bf16(rr[2], rr[3]); q.z = cvt_pk_bf16(rr[4], rr[5]); q.w = cvt_pk_bf16(rr[6], rr[7]);
                    const size_t g = (size_t)(row0 + ai * 128 + m * 16) * D + c0; *(u32x4*)(GA + g) = w; *(u32x4*)(GR + g) = q; }
            return true;
        }
        int kind, ld, colt; size_t off;
        if (pn < 6) { kind = 0; ld = AW; colt = pn * 256; off = WS_QA; }
        else if (pn < 12) { kind = 1; ld = AW; colt = (pn - 6) * 256; off = WS_KA; }
        else if (pn < 18) { kind = 1; ld = AW; colt = (pn - 12) * 256; off = WS_VA; }
        else if (pn < 22) { kind = 2; ld = BW; colt = (pn - 18) * 256; off = WS_QB; }
        else if (pn < 26) { kind = 3; ld = BW; colt = (pn - 22) * 256; off = WS_LOGF; }
        else if (pn < 30) { kind = 1; ld = BW; colt = (pn - 26) * 256; off = WS_IB; }
        else { kind = 4; ld = BW; colt = (pn - 30) * 256; off = WS_GB; }
        bf16_t* O = (bf16_t*)(ws + off);
#pragma unroll
        for (int bj = 0; bj < 2; ++bj) { const int c0 = colt + bj * 128 + cl;
            float gsc[8];
            if (kind == 4) {
#pragma unroll
                for (int j = 0; j < 8; ++j) gsc[j] = hng[c0 + j];
            } else if (kind == 3) {
#pragma unroll
                for (int j = 0; j < 8; ++j) gsc[j] = sigm(lbl[c0 + j] - lbl[BW + c0 + j]);
            }
#pragma unroll
            for (int ai = 0; ai < 2; ++ai)
#pragma unroll
                for (int m = 0; m < 4; ++m) { float v[8];
#pragma unroll
                    for (int j = 0; j < 4; ++j) { v[j] = acc[ai][bj][m][0][j]; v[4 + j] = acc[ai][bj][m][1][j]; }
                    if (kind == 0) {
#pragma unroll
                        for (int j = 0; j < 8; ++j) v[j] *= QSCALE;
                    } else if (kind == 2) {
#pragma unroll
                        for (int j = 0; j < 8; ++j) v[j] *= sigm(v[j]);
                    } else if (kind == 3) {
#pragma unroll
                        for (int j = 0; j < 8; ++j) v[j] = lg2(gsc[j] + (1.f - gsc[j]) * sigm(v[j])) * LN2;
                    } else if (kind == 4) {
#pragma unroll
                        for (int j = 0; j < 8; ++j) v[j] *= sigm(v[j]) * gsc[j];
                    }
                    u32x4 w; w.x = cvt_pk_bf16(v[0], v[1]); w.y = cvt_pk_bf16(v[2], v[3]); w.z = cvt_pk_bf16(v[4], v[5]); w.w = cvt_pk_bf16(v[6], v[7]);
                    *(u32x4*)(O + (size_t)(row0 + ai * 128 + m * 16) * ld + c0) = w; } }
        return true;
    }
};

__device__ __forceinline__ s16x4 tr_read2(unsigned a0, unsigned a1, s16x4& r1) {
    s16x4 r0; asm volatile("ds_read_b64_tr_b16 %0, %2\n\tds_read_b64_tr_b16 %1, %3\n\ts_waitcnt lgkmcnt(0)" : "=&v"(r0), "=&v"(r1) : "v"(a0), "v"(a1) : "memory"); return r0;
}
struct KVRegs { u32x4 k[8], v[8]; };
struct AUnit { int cfg, hd, r, bu; };
template <int NBLK> __device__ __forceinline__ AUnit attn_decode(int cfg, int u) {
    const int dsh = cfg * 2, nbu = (64 >> dsh) / NBLK, lgu = 6 - dsh - (NBLK == 2 ? 1 : 0), rest = u >> lgu;
    return AUnit{cfg, rest >> dsh, rest & ((1 << dsh) - 1), u & (nbu - 1)};
}
template <int BLK> __device__ __forceinline__ void kv_load(Frame& F, const AUnit& a, int b, KVRegs& R) {
    const bf16_t* KA = WSP(bf16_t, WS_KA); const bf16_t* VA = WSP(bf16_t, WS_VA); const int dsh = a.cfg * 2;
#pragma unroll
    for (int it = 0; it < (BLK == 0 ? 8 : 4); ++it) { const int row = (F.tid >> 4) + 32 * it, ch = F.tid & 15; int kidx = (BLK == 0 ? 128 * (b - 1) : 128 * b) + row; kidx = kidx < 0 ? 0 : kidx;
        const size_t g = (size_t)((kidx << dsh) + a.r) * AW + a.hd * 128 + ch * 8;
        R.k[it] = *(const u32x4*)(KA + g); R.v[it] = *(const u32x4*)(VA + g); }
}
template <int BLK> __device__ __forceinline__ void kv_commit(Frame& F, const KVRegs& R) {
    LAS unsigned char* Ks = F.lds; LAS unsigned char* Vs = F.lds + 73728;
#pragma unroll
    for (int it = 0; it < (BLK == 0 ? 8 : 4); ++it) { const int row = (F.tid >> 4) + 32 * it, ch = F.tid & 15;
        *(LAS u32x4*)(Ks + row * 288 + ch * 16) = R.k[it]; *(LAS u32x4*)(Vs + row * 288 + ch * 16) = R.v[it]; }
}
template <bool PH2> __device__ __forceinline__ void attn_phase(Frame& F) {
    constexpr bool MERGE = !PH2; constexpr int NBLK = PH2 ? 2 : 1; constexpr int NU = 768;
    const bf16_t* QA = WSP(bf16_t, WS_QA);
    LAS unsigned char* Ks = F.lds; LAS unsigned char* Vs = F.lds + 73728;
    const int lane = F.lane, w = F.wave, fr = lane & 15, fq = lane >> 4;
    if (F.vcu >= NU) return;
    KVRegs R;
    AUnit a = PH2 ? attn_decode<NBLK>(F.vcu >= 384 ? 1 : 0, F.vcu >= 384 ? F.vcu - 384 : F.vcu) : attn_decode<NBLK>(2, F.vcu);
    kv_load<0>(F, a, a.bu * NBLK, R);
    for (int u = F.vcu; u < NU; u += F.G) {
    const int un = u + F.G;
    const AUnit an = un < NU ? (PH2 ? attn_decode<NBLK>(un >= 384 ? 1 : 0, un >= 384 ? un - 384 : un) : attn_decode<NBLK>(2, un)) : a;
    const int cfg = a.cfg, dsh = cfg * 2, r = a.r, hd = a.hd;
#pragma unroll
    for (int blk = 0; blk < NBLK; ++blk) {
    const int b = a.bu * NBLK + blk, sw = blk << 7;
    if (blk == 0) kv_commit<0>(F, R); else kv_commit<1>(F, R);
    const int qi = 16 * w + fr; const size_t qpos = (size_t)(((128 * b + qi) << dsh) + r);
    bf16x8 qf[4];
#pragma unroll
    for (int kk = 0; kk < 4; ++kk) qf[kk] = *(const bf16x8*)(QA + qpos * AW + hd * 128 + 32 * kk + 8 * fq);
    float l1 = 0.f, l4 = 0.f;
    if constexpr (MERGE) { l1 = WSP(float, WS_LSE1)[qpos * AH + hd]; l4 = WSP(float, WS_LSE4)[qpos * AH + hd]; }
    __syncthreads();
    const int g0 = w >> 1;
    f32x4 S[10];
#pragma unroll
    for (int ti = 0; ti < 10; ++ti) { S[ti] = (f32x4){0.f, 0.f, 0.f, 0.f}; const int kb = (32 * g0 + 16 * ti) ^ sw;
#pragma unroll
        for (int kk = 0; kk < 4; ++kk) { const bf16x8 X = *(const LAS bf16x8*)(Ks + (kb + fr) * 288 + (32 * kk + 8 * fq) * 2);
            S[ti] = __builtin_amdgcn_mfma_f32_16x16x32_bf16(X, qf[kk], S[ti], 0, 0, 0); } }
    float mx = -INFINITY;
#pragma unroll
    for (int ti = 0; ti < 10; ++ti)
#pragma unroll
        for (int e = 0; e < 4; ++e) { const int j = 32 * g0 + 16 * ti + 4 * fq + e; const bool ok = (j >= qi) && (j <= qi + 128) && (b > 0 || j >= 128);
            S[ti][e] = ok ? S[ti][e] : -INFINITY; mx = fmaxf(mx, S[ti][e]); }
    mx = fmaxf(mx, __shfl_xor(mx, 16)); mx = fmaxf(mx, __shfl_xor(mx, 32));
    float l = 0.f; unsigned pk[10][2];
#pragma unroll
    for (int ti = 0; ti < 10; ++ti) { float p[4];
#pragma unroll
        for (int e = 0; e < 4; ++e) { p[e] = ex2(S[ti][e] - mx); l += p[e]; }
        pk[ti][0] = cvt_pk_bf16(p[0], p[1]); pk[ti][1] = cvt_pk_bf16(p[2], p[3]); }
    l += __shfl_xor(l, 16); l += __shfl_xor(l, 32);
    asm volatile("" ::: "memory");
    if (blk + 1 < NBLK) kv_load<1>(F, a, b + 1, R); else if (un < NU) kv_load<0>(F, an, an.bu * NBLK, R);
    asm volatile("" ::: "memory");
    f32x4 acc[8];
#pragma unroll
    for (int dt = 0; dt < 8; ++dt) acc[dt] = (f32x4){0.f, 0.f, 0.f, 0.f};
    const unsigned vbase = (unsigned)(size_t)Vs + (unsigned)((fr & 3) * 8);
    const int vrow = 4 * fq + (fr >> 2);
#pragma unroll
    for (int g = 0; g < 5; ++g) {
        u32x4 yw; yw.x = pk[2 * g][0]; yw.y = pk[2 * g][1]; yw.z = pk[2 * g + 1][0]; yw.w = pk[2 * g + 1][1];
        const bf16x8 Y = __builtin_bit_cast(bf16x8, yw);
        const unsigned ra = vbase + (unsigned)(((32 * (g0 + g) + vrow) ^ sw) * 288), rb2 = vbase + (unsigned)(((32 * (g0 + g) + 16 + vrow) ^ sw) * 288);
#pragma unroll
        for (int dt = 0; dt < 8; ++dt) { s16x4 x1; const s16x4 x0 = tr_read2(ra + dt * 32, rb2 + dt * 32, x1);
            bf16x8 X; X[0] = x0[0]; X[1] = x0[1]; X[2] = x0[2]; X[3] = x0[3]; X[4] = x1[0]; X[5] = x1[1]; X[6] = x1[2]; X[7] = x1[3];
            acc[dt] = __builtin_amdgcn_mfma_f32_16x16x32_bf16(X, Y, acc[dt], 0, 0, 0); }
    }
    const float inv = 1.0f / l, lse = mx + lg2(l);
    if constexpr (!MERGE) {
        bf16_t* O = cfg == 0 ? WSP(bf16_t, WS_O1) : WSP(bf16_t, WS_O4); float* L = cfg == 0 ? WSP(float, WS_LSE1) : WSP(float, WS_LSE4);
#pragma unroll
        for (int dt = 0; dt < 8; ++dt) { u32x2 o; o.x = cvt_pk_bf16(acc[dt][0] * inv, acc[dt][1] * inv); o.y = cvt_pk_bf16(acc[dt][2] * inv, acc[dt][3] * inv);
            *(u32x2*)(O + qpos * AW + hd * 128 + 16 * dt + 4 * fq) = o; }
        if (fq == 0) L[qpos * AH + hd] = lse;
    } else {
        const float M = fmaxf(fmaxf(l1, l4), lse); const float w1 = ex2(l1 - M), w4 = ex2(l4 - M), w16 = ex2(lse - M); const float iw = 1.0f / (w1 + w4 + w16);
        const float c1 = w1 * iw, c4 = w4 * iw, c16 = w16 * iw * inv;
        const bf16_t* O1 = WSP(bf16_t, WS_O1); const bf16_t* O4 = WSP(bf16_t, WS_O4); bf16_t* OA = WSP(bf16_t, WS_OA);
#pragma unroll
        for (int dt = 0; dt < 8; ++dt) { const size_t g = qpos * AW + hd * 128 + 16 * dt + 4 * fq; const u32x2 a1 = *(const u32x2*)(O1 + g), c = *(const u32x2*)(O4 + g);
            u32x2 o; o.x = cvt_pk_bf16(c1 * bf_lo(a1.x) + c4 * bf_lo(c.x) + c16 * acc[dt][0], c1 * bf_hi(a1.x) + c4 * bf_hi(c.x) + c16 * acc[dt][1]);
            o.y = cvt_pk_bf16(c1 * bf_lo(a1.y) + c4 * bf_lo(c.y) + c16 * acc[dt][2], c1 * bf_hi(a1.y) + c4 * bf_hi(c.y) + c16 * acc[dt][3]);
            *(u32x2*)(OA + g) = o; }
    }
    __syncthreads();
    }
    a = an;
    }
}

constexpr int HG_LF = 0, HG_BC = 33792, HG_VS = 67584, HG_SS = 86016, HG_RED = 120832;
struct HgTile { u32x4 lf[2], vv[2], sv[4]; };
template <bool WITH_STATE> __device__ __forceinline__ void hg_load(Frame& F, int u, HgTile& t) {
    const int hd = u >> 7, c = u & 127;
    const bf16_t* LOGF = WSP(bf16_t, WS_LOGF); const bf16_t* IB = WSP(bf16_t, WS_IB);
#pragma unroll
    for (int it = 0; it < 2; ++it) { const int idx = F.tid + 512 * it, row = idx >> 4, ch = idx & 15; const size_t g = (size_t)(64 * c + row) * BW + hd * 128 + 8 * ch;
        t.lf[it] = *(const u32x4*)(LOGF + g); t.vv[it] = *(const u32x4*)(IB + g); }
    if constexpr (WITH_STATE) { const bf16_t* ST = WSP(bf16_t, WS_ST) + ((size_t)(hd * 128 + c) * 128) * 128;
#pragma unroll
        for (int it = 0; it < 4; ++it) t.sv[it] = *(const u32x4*)(ST + (size_t)(F.tid + 512 * it) * 8); }
}
template <bool WITH_STATE> __device__ __forceinline__ void hg_commit(Frame& F, const HgTile& t) {
    LAS float* LF = (LAS float*)(F.lds + HG_LF); LAS float* BC = (LAS float*)(F.lds + HG_BC); LAS unsigned char* Vs = F.lds + HG_VS; LAS unsigned char* SS = F.lds + HG_SS;
#pragma unroll
    for (int it = 0; it < 2; ++it) { const int idx = F.tid + 512 * it, row = idx >> 4, ch = idx & 15;
        *(LAS f32x4*)(LF + row * 132 + 8 * ch) = (f32x4){bf_lo(t.lf[it].x), bf_hi(t.lf[it].x), bf_lo(t.lf[it].y), bf_hi(t.lf[it].y)};
        *(LAS f32x4*)(LF + row * 132 + 8 * ch + 4) = (f32x4){bf_lo(t.lf[it].z), bf_hi(t.lf[it].z), bf_lo(t.lf[it].w), bf_hi(t.lf[it].w)};
        *(LAS u32x4*)(Vs + row * 288 + ch * 16) = t.vv[it]; }
    if constexpr (WITH_STATE) {
#pragma unroll
        for (int it = 0; it < 4; ++it) { const int idx = F.tid + 512 * it, v = idx >> 4, k8 = idx & 15; *(LAS u32x4*)(SS + v * 272 + k8 * 16) = t.sv[it]; } }
    __syncthreads();
    if (F.tid < 128) { float run = 0.f;
#pragma unroll 8
        for (int s = 0; s < 64; ++s) { run += LF[s * 132 + F.tid]; BC[s * 132 + F.tid] = run; } }
    __syncthreads();
}
__device__ __forceinline__ void hgrn_local_unit(Frame& F, int u, HgTile& t, int unext) {
    const int hd = u >> 7, c = u & 127;
    hg_commit<false>(F, t);
    if (unext < BH * NCH) hg_load<false>(F, unext, t);
    LAS float* LF = (LAS float*)(F.lds + HG_LF); LAS float* BC = (LAS float*)(F.lds + HG_BC); LAS unsigned char* Vs = F.lds + HG_VS;
    const int lane = F.lane, w = F.wave, fr = lane & 15, fq = lane >> 4, kch = 16 * w + fr;
    const float blast = BC[63 * 132 + kch];
    bf16x8 X[2];
#pragma unroll
    for (int ks = 0; ks < 2; ++ks) { float v[8];
#pragma unroll
        for (int j = 0; j < 8; ++j) { const int s = 32 * ks + 8 * fq + j; v[j] = (1.0f - expn(LF[s * 132 + kch])) * expn(blast - BC[s * 132 + kch]); }
        u32x4 xw; xw.x = cvt_pk_bf16(v[0], v[1]); xw.y = cvt_pk_bf16(v[2], v[3]); xw.z = cvt_pk_bf16(v[4], v[5]); xw.w = cvt_pk_bf16(v[6], v[7]); X[ks] = __builtin_bit_cast(bf16x8, xw); }
    const unsigned vbase = (unsigned)(size_t)Vs + (unsigned)((8 * fq + (fr >> 2)) * 288 + (fr & 3) * 8);
    bf16_t* ST = WSP(bf16_t, WS_ST) + ((size_t)(hd * 128 + c) * 128) * 128;
#pragma unroll
    for (int vt = 0; vt < 8; ++vt) { f32x4 a = (f32x4){0.f, 0.f, 0.f, 0.f};
#pragma unroll
        for (int ks = 0; ks < 2; ++ks) { const unsigned rb = vbase + (unsigned)(32 * ks) * 288u + vt * 32; s16x4 y1; const s16x4 y0 = tr_read2(rb, rb + 4 * 288, y1);
            bf16x8 Y; Y[0] = y0[0]; Y[1] = y0[1]; Y[2] = y0[2]; Y[3] = y0[3]; Y[4] = y1[0]; Y[5] = y1[1]; Y[6] = y1[2]; Y[7] = y1[3];
            a = __builtin_amdgcn_mfma_f32_16x16x32_bf16(X[ks], Y, a, 0, 0, 0); }
        u32x2 o; o.x = cvt_pk_bf16(a[0], a[1]); o.y = cvt_pk_bf16(a[2], a[3]); *(u32x2*)(ST + (size_t)(16 * vt + fr) * 128 + 16 * w + 4 * fq) = o; }
    if (F.tid < 128) WSP(float, WS_DEC)[(hd * 128 + c) * 128 + F.tid] = expn(BC[63 * 132 + F.tid]);
    __syncthreads();
}
template <bool DRY> __device__ __forceinline__ void hgrn_scan(Frame& F) {
    unsigned* ST = WSP(unsigned, WS_ST); const float* DEC = WSP(float, WS_DEC); unsigned* DUM = WSP(unsigned, WS_XN);
    LAS float* DL = (LAS float*)F.lds;
    for (int base = F.vcu * 256; base < BH * 8192; base += F.G * 256) {
        const int hd = base >> 13;
        { const f32x4* src = (const f32x4*)(DEC + hd * 128 * 128);
#pragma unroll
          for (int it = 0; it < 8; ++it) { const int i = F.tid + 512 * it; *(LAS f32x4*)(DL + 4 * i) = src[i]; } }
        __syncthreads();
        if (F.tid < 256) {
            const int idx = base + F.tid, vk2 = idx & 8191, k2 = vk2 & 63;
            unsigned* p = ST + (size_t)hd * 128 * 8192 + vk2; const LAS f32x2* d = (const LAS f32x2*)DL + k2;
            float S0 = 0.f, S1 = 0.f;
            for (int c0 = 0; c0 < NCH; c0 += 32) { unsigned tv[32];
#pragma unroll
                for (int j = 0; j < 32; ++j) tv[j] = p[(size_t)(c0 + j) * 8192];
#pragma unroll
                for (int j = 0; j < 32; ++j) { const unsigned o = cvt_pk_bf16(S0, S1); const f32x2 dv = d[(c0 + j) * 64];
                    if (DRY) DUM[(((size_t)hd * 128 + (c0 + j)) * 8192 + vk2) & (8u * 1024 * 1024 - 1)] = o; else p[(size_t)(c0 + j) * 8192] = o;
                    S0 = dv.x * S0 + bf_lo(tv[j]); S1 = dv.y * S1 + bf_hi(tv[j]); } }
        }
        __syncthreads();
    }
}
__device__ __forceinline__ void hgrn_out_unit(Frame& F, int u, HgTile& t, int unext) {
    const int hd = u >> 7, c = u & 127;
    LAS float* LF = (LAS float*)(F.lds + HG_LF); LAS float* BC = (LAS float*)(F.lds + HG_BC); LAS unsigned char* Vs = F.lds + HG_VS; LAS unsigned char* SS = F.lds + HG_SS; LAS float* RED = (LAS float*)(F.lds + HG_RED);
    hg_commit<true>(F, t);
    const int lane = F.lane, w = F.wave, fr = lane & 15, fq = lane >> 4, i = w >> 1, vh = w & 1;
    const bf16_t* QB = WSP(bf16_t, WS_QB);
    const size_t trow = (size_t)(64 * c + 16 * i + fr);
    bf16x8 qi_f[4], q0_f[4]; float bi[32];
    u32x4 qraw[4]; u32x2 gbv[4]; const bf16_t* GB = WSP(bf16_t, WS_GB);
#pragma unroll
    for (int kk = 0; kk < 4; ++kk) qraw[kk] = *(const u32x4*)(QB + trow * BW + hd * 128 + 32 * kk + 8 * fq);
#pragma unroll
    for (int vt = 0; vt < 4; ++vt) gbv[vt] = *(const u32x2*)(GB + trow * BW + hd * 128 + 16 * (4 * vh + vt) + 4 * fq);
    asm volatile("" ::: "memory");
    if (unext < BH * NCH) hg_load<true>(F, unext, t);
    asm volatile("" ::: "memory");
#pragma unroll
    for (int kk = 0; kk < 4; ++kk) { const u32x4 qw = qraw[kk];
        const float q[8] = {bf_lo(qw.x), bf_hi(qw.x), bf_lo(qw.y), bf_hi(qw.y), bf_lo(qw.z), bf_hi(qw.z), bf_lo(qw.w), bf_hi(qw.w)};
        float a[8], z[8];
#pragma unroll
        for (int j = 0; j < 8; ++j) { const int k = 32 * kk + 8 * fq + j; const float bct = BC[(16 * i + fr) * 132 + k]; const float b = i ? BC[(16 * i - 1) * 132 + k] : 0.f; bi[kk * 8 + j] = b;
            a[j] = q[j] * expn(bct - b); z[j] = q[j] * expn(bct); }
        u32x4 aw, zw; aw.x = cvt_pk_bf16(a[0], a[1]); aw.y = cvt_pk_bf16(a[2], a[3]); aw.z = cvt_pk_bf16(a[4], a[5]); aw.w = cvt_pk_bf16(a[6], a[7]);
        zw.x = cvt_pk_bf16(z[0], z[1]); zw.y = cvt_pk_bf16(z[2], z[3]); zw.z = cvt_pk_bf16(z[4], z[5]); zw.w = cvt_pk_bf16(z[6], z[7]);
        qi_f[kk] = __builtin_bit_cast(bf16x8, aw); q0_f[kk] = __builtin_bit_cast(bf16x8, zw); }
    unsigned pk[4][2];
#pragma unroll
    for (int j = 0; j < 4; ++j) {
        pk[j][0] = 0u; pk[j][1] = 0u;
        if (j <= i) {
            f32x4 a = (f32x4){0.f, 0.f, 0.f, 0.f}; const int s = 16 * j + fr;
#pragma unroll
            for (int kk = 0; kk < 4; ++kk) { float v[8];
#pragma unroll
                for (int jj = 0; jj < 8; ++jj) { const int k = 32 * kk + 8 * fq + jj; v[jj] = (1.0f - expn(LF[s * 132 + k])) * expn(fminf(bi[kk * 8 + jj] - BC[s * 132 + k], 80.f)); }
                u32x4 xw; xw.x = cvt_pk_bf16(v[0], v[1]); xw.y = cvt_pk_bf16(v[2], v[3]); xw.z = cvt_pk_bf16(v[4], v[5]); xw.w = cvt_pk_bf16(v[6], v[7]);
                a = __builtin_amdgcn_mfma_f32_16x16x32_bf16(__builtin_bit_cast(bf16x8, xw), qi_f[kk], a, 0, 0, 0); }
            if (j == i) {
#pragma unroll
                for (int e = 0; e < 4; ++e) a[e] = (4 * fq + e <= fr) ? a[e] : 0.f;
            }
            pk[j][0] = cvt_pk_bf16(a[0], a[1]); pk[j][1] = cvt_pk_bf16(a[2], a[3]);
        }
    }
    f32x4 acc[4];
#pragma unroll
    for (int vt = 0; vt < 4; ++vt) acc[vt] = (f32x4){0.f, 0.f, 0.f, 0.f};
    const unsigned vbase = (unsigned)(size_t)Vs + (unsigned)((4 * fq + (fr >> 2)) * 288 + (fr & 3) * 8);
#pragma unroll
    for (int g2 = 0; g2 < 2; ++g2) {
        if (2 * g2 <= i) {
            u32x4 yw; yw.x = pk[2 * g2][0]; yw.y = pk[2 * g2][1]; yw.z = pk[2 * g2 + 1][0]; yw.w = pk[2 * g2 + 1][1]; const bf16x8 Y = __builtin_bit_cast(bf16x8, yw);
#pragma unroll
            for (int vt = 0; vt < 4; ++vt) { const unsigned rb = vbase + (unsigned)(32 * g2) * 288u + (unsigned)(4 * vh + vt) * 32u; s16x4 x1; const s16x4 x0 = tr_read2(rb, rb + 16 * 288, x1);
                bf16x8 X; X[0] = x0[0]; X[1] = x0[1]; X[2] = x0[2]; X[3] = x0[3]; X[4] = x1[0]; X[5] = x1[1]; X[6] = x1[2]; X[7] = x1[3];
                acc[vt] = __builtin_amdgcn_mfma_f32_16x16x32_bf16(X, Y, acc[vt], 0, 0, 0); }
        }
    }
#pragma unroll
    for (int kk = 0; kk < 4; ++kk)
#pragma unroll
        for (int vt = 0; vt < 4; ++vt) { const bf16x8 X = *(const LAS bf16x8*)(SS + (16 * (4 * vh + vt) + fr) * 272 + (32 * kk + 8 * fq) * 2);
            acc[vt] = __builtin_amdgcn_mfma_f32_16x16x32_bf16(X, q0_f[kk], acc[vt], 0, 0, 0); }
    float ss = 0.f;
#pragma unroll
    for (int vt = 0; vt < 4; ++vt) ss += (acc[vt][0] * acc[vt][0] + acc[vt][1] * acc[vt][1]) + (acc[vt][2] * acc[vt][2] + acc[vt][3] * acc[vt][3]);
    ss += __shfl_xor(ss, 16); ss += __shfl_xor(ss, 32);
    if (fq == 0) RED[vh * 64 + 16 * i + fr] = ss;
    __syncthreads();
    const float rstd = __builtin_amdgcn_rsqf((RED[16 * i + fr] + RED[64 + 16 * i + fr]) * (1.f / 128.f) + EPS);
    bf16_t* OB = WSP(bf16_t, WS_OB);
#pragma unroll
    for (int vt = 0; vt < 4; ++vt) { const size_t g = trow * BW + hd * 128 + 16 * (4 * vh + vt) + 4 * fq; const u32x2 gb = gbv[vt];
        u32x2 o; o.x = cvt_pk_bf16(acc[vt][0] * rstd * bf_lo(gb.x), acc[vt][1] * rstd * bf_hi(gb.x)); o.y = cvt_pk_bf16(acc[vt][2] * rstd * bf_lo(gb.y), acc[vt][3] * rstd * bf_hi(gb.y));
        *(u32x2*)(OB + g) = o; }
    __syncthreads();
}

struct MergedSched {
    static constexpr bool GATHER = false, HALFABLE = false;
    const bf16_t *OA, *WA, *OB, *WB; ListOrder so;
    __device__ __forceinline__ bool next(int i, pg8::Unit& u) const { if (!so.next(i >> 1, u)) return false; u.aux = i & 1; return true; }
    __device__ __forceinline__ int kdim(const pg8::Unit& u) const { return u.aux ? AW : BW; }
    __device__ __forceinline__ const char* a_base(const pg8::Unit& u) const { return u.aux ? (const char*)OA + (size_t)u.pm * 256 * AW * 2 : (const char*)OB + (size_t)u.pm * 256 * BW * 2; }
    __device__ __forceinline__ const char* b_base(const pg8::Unit& u) const { return u.aux ? (const char*)WA + (size_t)u.pn * 256 * AW * 2 : (const char*)WB + (size_t)u.pn * 256 * BW * 2; }
};
struct EpiMerged {
    static constexpr bool STORES16 = false;
    const bf16_t *GA, *GR; bf16_t* O;
    __device__ __forceinline__ bool operator()(f32x4 (&acc)[2][2][4][2], const pg8::Unit& u, int wr, int wc, int fr, int fq) const {
        const int row0 = u.pm * 256 + wr * 64 + fr, col0 = u.pn * 256 + wc * 32 + 8 * fq; const bf16_t* Gs = u.aux ? GA : GR;
#pragma unroll
        for (int ai = 0; ai < 2; ++ai)
#pragma unroll
            for (int m = 0; m < 4; ++m)
#pragma unroll
                for (int bj = 0; bj < 2; ++bj) { const size_t g = (size_t)(row0 + ai * 128 + m * 16) * D + col0 + bj * 128;
                    const u32x4 a = *(const u32x4*)(Gs + g);
                    const float sa[8] = {bf_lo(a.x), bf_hi(a.x), bf_lo(a.y), bf_hi(a.y), bf_lo(a.z), bf_hi(a.z), bf_lo(a.w), bf_hi(a.w)};
                    if (u.aux == 0) {
#pragma unroll
                        for (int j = 0; j < 4; ++j) { acc[ai][bj][m][0][j] *= sa[j]; acc[ai][bj][m][1][j] *= sa[4 + j]; }
                    } else { u32x4 w; w.x = cvt_pk_bf16(acc[ai][bj][m][0][0] * sa[0], acc[ai][bj][m][0][1] * sa[1]); w.y = cvt_pk_bf16(acc[ai][bj][m][0][2] * sa[2], acc[ai][bj][m][0][3] * sa[3]);
                        w.z = cvt_pk_bf16(acc[ai][bj][m][1][0] * sa[4], acc[ai][bj][m][1][1] * sa[5]); w.w = cvt_pk_bf16(acc[ai][bj][m][1][2] * sa[6], acc[ai][bj][m][1][3] * sa[7]);
                        *(u32x4*)(O + g) = w; } }
        return u.aux != 0;
    }
};
struct EpiResid {   static constexpr bool STORES16 = false;
    bf16_t* O;
    __device__ __forceinline__ bool operator()(f32x4 (&acc)[2][2][4][2], const pg8::Unit& u, int wr, int wc, int fr, int fq) const {
        const int row0 = u.pm * 256 + wr * 64 + fr, col0 = u.pn * 256 + wc * 32 + 8 * fq;
#pragma unroll
        for (int ai = 0; ai < 2; ++ai)
#pragma unroll
            for (int m = 0; m < 4; ++m)
#pragma unroll
                for (int bj = 0; bj < 2; ++bj) { const size_t g = (size_t)(row0 + ai * 128 + m * 16) * D + col0 + bj * 128;
                    u32x4 w; w.x = cvt_pk_bf16(acc[ai][bj][m][0][0], acc[ai][bj][m][0][1]); w.y = cvt_pk_bf16(acc[ai][bj][m][0][2], acc[ai][bj][m][0][3]);
                    w.z = cvt_pk_bf16(acc[ai][bj][m][1][0], acc[ai][bj][m][1][1]); w.w = cvt_pk_bf16(acc[ai][bj][m][1][2], acc[ai][bj][m][1][3]);
                    *(u32x4*)(O + g) = w; }
        return true;
    }
};

struct RTile { f32x4 ha[2], hb[2], w0[2], w1[2], w2[2]; u32x4 ma, mb; };
__device__ __forceinline__ void rt_load(RTile& r, const float* Ha, const float* Hb, const bf16_t* Ma, const bf16_t* Mb, const float* WTR, int tk, int kb) {
    r.ma = *(const u32x4*)(Ma + kb); r.mb = *(const u32x4*)(Mb + kb);
#pragma unroll
    for (int s = 0; s < 2; ++s) { r.ha[s] = *(const f32x4*)(Ha + kb + 4 * s); r.hb[s] = *(const f32x4*)(Hb + kb + 4 * s);
        r.w0[s] = tk < 4 ? *(const f32x4*)(WTR + (size_t)tk * D + kb + 4 * s) : (f32x4){0.f, 0.f, 0.f, 0.f};
        r.w1[s] = *(const f32x4*)(WTR + (size_t)(16 + tk) * D + kb + 4 * s); r.w2[s] = *(const f32x4*)(WTR + (size_t)(32 + tk) * D + kb + 4 * s); }
}
template <bool DRY> __device__ __forceinline__ void p7_router(Frame& F) {
    const int lane = F.lane, w = F.wave, tk = lane & 15, kq = lane >> 4;
    const float* WTR = WSP(float, WS_WTR);
    LAS float* PART = (LAS float*)F.lds;
    for (int pair = F.vcu; pair < T / 32; pair += F.G) {
        const int t0 = 32 * pair;
        const float* Ha = F.in[0] + (size_t)(t0 + tk) * D; const float* Hb = Ha + (size_t)16 * D;
        const bf16_t* Ma = WSP(bf16_t, WS_HM) + (size_t)(t0 + tk) * D; const bf16_t* Mb = Ma + (size_t)16 * D;
        bf16_t* Na = (DRY ? WSP(bf16_t, WS_W2) : WSP(bf16_t, WS_XN)) + (size_t)(t0 + tk) * D; bf16_t* Nb = Na + (size_t)16 * D;
        f32x4 a0 = (f32x4){0.f, 0.f, 0.f, 0.f}, a1 = a0, a2 = a0, b0 = a0, b1 = a0, b2 = a0; float ssa = 0.f, ssb = 0.f;
        RTile cur, nxt; rt_load(cur, Ha, Hb, Ma, Mb, WTR, tk, 256 * w + 8 * kq);
#pragma unroll 1
        for (int j = 0; j < 8; ++j) {
            const int kb = 256 * w + 32 * j + 8 * kq, jn = (j + 1) & 7;
            rt_load(nxt, Ha, Hb, Ma, Mb, WTR, tk, 256 * w + 32 * jn + 8 * kq);
            asm volatile("" ::: "memory");
            cur.ha[0] = cur.ha[0] + (f32x4){bf_lo(cur.ma.x), bf_hi(cur.ma.x), bf_lo(cur.ma.y), bf_hi(cur.ma.y)}; cur.ha[1] = cur.ha[1] + (f32x4){bf_lo(cur.ma.z), bf_hi(cur.ma.z), bf_lo(cur.ma.w), bf_hi(cur.ma.w)};
            cur.hb[0] = cur.hb[0] + (f32x4){bf_lo(cur.mb.x), bf_hi(cur.mb.x), bf_lo(cur.mb.y), bf_hi(cur.mb.y)}; cur.hb[1] = cur.hb[1] + (f32x4){bf_lo(cur.mb.z), bf_hi(cur.mb.z), bf_lo(cur.mb.w), bf_hi(cur.mb.w)};
#pragma unroll
            for (int s = 0; s < 2; ++s) { ssa += (cur.ha[s].x * cur.ha[s].x + cur.ha[s].y * cur.ha[s].y) + (cur.ha[s].z * cur.ha[s].z + cur.ha[s].w * cur.ha[s].w);
                ssb += (cur.hb[s].x * cur.hb[s].x + cur.hb[s].y * cur.hb[s].y) + (cur.hb[s].z * cur.hb[s].z + cur.hb[s].w * cur.hb[s].w); }
            u32x4 oa, ob;
            oa.x = cvt_pk_bf16(cur.ha[0].x, cur.ha[0].y); oa.y = cvt_pk_bf16(cur.ha[0].z, cur.ha[0].w); oa.z = cvt_pk_bf16(cur.ha[1].x, cur.ha[1].y); oa.w = cvt_pk_bf16(cur.ha[1].z, cur.ha[1].w);
            ob.x = cvt_pk_bf16(cur.hb[0].x, cur.hb[0].y); ob.y = cvt_pk_bf16(cur.hb[0].z, cur.hb[0].w); ob.z = cvt_pk_bf16(cur.hb[1].x, cur.hb[1].y); ob.w = cvt_pk_bf16(cur.hb[1].z, cur.hb[1].w);
            *(u32x4*)(Na + kb) = oa; *(u32x4*)(Nb + kb) = ob;
#pragma unroll
            for (int s = 0; s < 2; ++s)
#pragma unroll
                for (int e = 0; e < 4; ++e) { a0 = __builtin_amdgcn_mfma_f32_16x16x4f32(cur.ha[s][e], cur.w0[s][e], a0, 0, 0, 0); a1 = __builtin_amdgcn_mfma_f32_16x16x4f32(cur.ha[s][e], cur.w1[s][e], a1, 0, 0, 0); a2 = __builtin_amdgcn_mfma_f32_16x16x4f32(cur.ha[s][e], cur.w2[s][e], a2, 0, 0, 0);
                    b0 = __builtin_amdgcn_mfma_f32_16x16x4f32(cur.hb[s][e], cur.w0[s][e], b0, 0, 0, 0); b1 = __builtin_amdgcn_mfma_f32_16x16x4f32(cur.hb[s][e], cur.w1[s][e], b1, 0, 0, 0); b2 = __builtin_amdgcn_mfma_f32_16x16x4f32(cur.hb[s][e], cur.w2[s][e], b2, 0, 0, 0); }
            cur = nxt;
        }
        ssa += __shfl_xor(ssa, 16); ssa += __shfl_xor(ssa, 32); ssb += __shfl_xor(ssb, 16); ssb += __shfl_xor(ssb, 32);
        { LAS float* P = PART + w * 1664;
#pragma unroll
          for (int e = 0; e < 4; ++e) { P[(4 * kq + e) * 52 + tk] = a0[e]; P[(4 * kq + e) * 52 + 16 + tk] = a1[e]; P[(4 * kq + e) * 52 + 32 + tk] = a2[e];
              P[832 + (4 * kq + e) * 52 + tk] = b0[e]; P[832 + (4 * kq + e) * 52 + 16 + tk] = b1[e]; P[832 + (4 * kq + e) * 52 + 32 + tk] = b2[e]; }
          if (kq == 0) { P[tk * 52 + 48] = ssa; P[832 + tk * 52 + 48] = ssb; } }
        __syncthreads();
        LAS unsigned* LC = (LAS unsigned*)(F.lds + 57344); LAS unsigned* LB = LC + 32;
        if (F.tid < 32) LC[F.tid] = 0u;
        __syncthreads();
        const bool router = (w < 2 && lane < 16);
        int e0 = 0, e1 = 0; unsigned rk0 = 0, rk1 = 0; float wt0 = 0.f, wt1 = 0.f, rstd = 0.f; const int t = t0 + 16 * (w & 1) + (lane & 15);
        if (router) {
            const LAS float* q = PART + (w & 1) * 832 + lane * 52; const float* rbg = F.in[10]; const float* rbe = F.in[12];
#define RSUM(o) (((q[(o)] + q[1664 + (o)]) + (q[3328 + (o)] + q[4992 + (o)])) + ((q[6656 + (o)] + q[8320 + (o)]) + (q[9984 + (o)] + q[11648 + (o)])))
            rstd = __builtin_amdgcn_rsqf(RSUM(48) * (1.f / D) + EPS);
            float gl[4]; int gi = 0; float gm;
#pragma unroll
            for (int o = 0; o < 4; ++o) gl[o] = RSUM(o) * rstd + rbg[o];
            gm = gl[0];
#pragma unroll
            for (int o = 1; o < 4; ++o) if (gl[o] > gm) { gm = gl[o]; gi = o; }
            float den = 0.f;
#pragma unroll
            for (int o = 0; o < 4; ++o) den += expn(gl[o] - gm);
            const float pg = 1.0f / den;
            float v0 = -INFINITY, v1 = -INFINITY; int i0 = 0, i1 = 0;
#pragma unroll
            for (int x = 0; x < 8; ++x) { const float v = RSUM(16 + 8 * gi + x) * rstd + rbe[8 * gi + x];
                if (v > v0) { v1 = v0; i1 = i0; v0 = v; i0 = x; } else if (v > v1) { v1 = v; i1 = x; } }
#undef RSUM
            const float p0 = 1.0f / (1.0f + expn(v1 - v0)), p1 = 1.0f - p0;
            e0 = 8 * gi + i0; e1 = 8 * gi + i1; wt0 = p0 * pg; wt1 = p1 * pg;
            rk0 = __hip_atomic_fetch_add(LC + e0, 1u, __ATOMIC_RELAXED, __HIP_MEMORY_SCOPE_WORKGROUP); rk1 = __hip_atomic_fetch_add(LC + e1, 1u, __ATOMIC_RELAXED, __HIP_MEMORY_SCOPE_WORKGROUP);
        }
        __syncthreads();
        if (F.tid < 32) { const unsigned n = LC[F.tid]; unsigned* CN = F.ctl + CW_CNT + (DRY ? 64 * NE : 0); LB[F.tid] = n ? atomicAdd(CN + 64 * F.tid, n) : 0u; }
        __syncthreads();
        if (router) {
            int* TL = DRY ? WSP(int, WS_W2 + 40 * MiB) : WSP(int, WS_TOKL); float* TW = DRY ? WSP(float, WS_W2 + 42 * MiB) : WSP(float, WS_TOKW);
            int* SP = DRY ? WSP(int, WS_W2 + 46 * MiB) : WSP(int, WS_SP); float* SW = DRY ? WSP(float, WS_W2 + 47 * MiB) : WSP(float, WS_SW);
            const unsigned pos0 = (LB[e0] + rk0) & (CAP - 1), pos1 = (LB[e1] + rk1) & (CAP - 1);
            TL[e0 * CAP + pos0] = 2 * t; TW[e0 * CAP + pos0] = wt0; SP[2 * t] = (e0 << 16) | (int)pos0; SW[2 * t] = wt0;
            TL[e1 * CAP + pos1] = 2 * t + 1; TW[e1 * CAP + pos1] = wt1; SP[2 * t + 1] = (e1 << 16) | (int)pos1; SW[2 * t + 1] = wt1;
            (DRY ? WSP(float, WS_W2 + 44 * MiB) : WSP(float, WS_RSTD))[t] = rstd;
        }
        __syncthreads();
    }
}
__device__ __forceinline__ TrItem p8_item(Frame& F, int it) { const int e = it >> 8, r2 = it & 255, kb = r2 >> 5, nb = r2 & 31;
    return TrItem{F.in[15] + (size_t)e * FF * D, WSP(bf16_t, WS_W2) + (size_t)e * D * FF, D, FF, 64 * kb, 64 * nb, 64 * nb, nullptr}; }
__device__ __forceinline__ void p8_filler(Frame& F, int li, int NL) {
    LAS float* scr = (LAS float*)(F.lds + F.wave * TSCR);
    const int gw = li * 8 + F.wave, NGW = NL * 8;
    for (int it = gw; it < NE * 256; it += 4 * NGW) {
        const int i1 = it + NGW, i2 = it + 2 * NGW, i3 = it + 3 * NGW;
        TrItem a = p8_item(F, it), b = p8_item(F, i1 < NE * 256 ? i1 : it);
        f32x4 va[16], vb[16];
        tr64_load<false>(va, a.W, a.ldw, a.k0, a.n0, F.lane); if (i1 < NE * 256) tr64_load<false>(vb, b.W, b.ldw, b.k0, b.n0, F.lane);
        tr64_finish<false>(va, a.k0, a.WT, a.ldt, a.drow0, scr, F.lane);
        if (i2 < NE * 256) { a = p8_item(F, i2); tr64_load<false>(va, a.W, a.ldw, a.k0, a.n0, F.lane); }
        if (i1 < NE * 256) tr64_finish<false>(vb, b.k0, b.WT, b.ldt, b.drow0, scr, F.lane);
        if (i3 < NE * 256) { b = p8_item(F, i3); tr64_load<false>(vb, b.W, b.ldw, b.k0, b.n0, F.lane); }
        if (i2 < NE * 256) tr64_finish<false>(va, a.k0, a.WT, a.ldt, a.drow0, scr, F.lane);
        if (i3 < NE * 256) tr64_finish<false>(vb, b.k0, b.WT, b.ldt, b.drow0, scr, F.lane);
    }
}

template <int NPN> __device__ __forceinline__ void moe_tables(Frame& F) {
    LAS int* TP = (LAS int*)(F.lds + MISC_OFF + 256); LAS int* RO = TP + 40; LAS int* CN = RO + 40; LAS int* UL = CN + 40; LAS int* TI = (LAS int*)(F.lds + MISC_OFF + 2048);
    if (F.tid < NE) { int n = (int)__hip_atomic_load(F.ctl + CW_CNT + 64 * F.tid, __ATOMIC_RELAXED, __HIP_MEMORY_SCOPE_AGENT); CN[F.tid] = n > CAP ? CAP : n; }
    __syncthreads();
    if (F.tid == 0) { int tp = 0, ro = 0;
        for (int e = 0; e < NE; ++e) { const int n = CN[e]; TP[e] = tp; RO[e] = ro; tp += (n + 255) >> 8; ro += n; }
        TP[NE] = tp; RO[NE] = ro;
        int k = 0;
        for (int e = 0; e < NE; ++e) { const int n = CN[e], nt = (n + 255) >> 8; for (int mt = 0; mt < nt; ++mt) if (n - 256 * mt > 128) TI[k++] = (e << 8) | mt; }
        for (int e = 0; e < NE; ++e) { const int n = CN[e], nt = (n + 255) >> 8; for (int mt = 0; mt < nt; ++mt) if (n - 256 * mt <= 128) TI[k++] = (e << 8) | mt; } }
    __syncthreads();
    if (F.tid < 8) { const int L = F.tid * F.G + F.vcu, total = TP[NE] * NPN; int e = 0, mt = 0, pn = 0;
        if (L < total) { const int ti = TI[L / NPN]; pn = L % NPN; e = ti >> 8; mt = ti & 255; }
        const int n = CN[e] - 256 * mt;
        UL[F.tid * 5 + 0] = (L < total) ? e : -1; UL[F.tid * 5 + 1] = mt; UL[F.tid * 5 + 2] = pn; UL[F.tid * 5 + 3] = n < 256 ? n : 256; UL[F.tid * 5 + 4] = RO[e] + 256 * mt; }
    __syncthreads();
}
struct MoeOrder {
    const LAS int* UL;
    __device__ __forceinline__ bool next(int i, pg8::Unit& u) const {
        if (i >= 8) return false; const int e = UL[i * 5]; if (e < 0) return false;
        u.aux = e; u.pm = UL[i * 5 + 1]; u.pn = UL[i * 5 + 2]; u.rows = UL[i * 5 + 3]; u.base = UL[i * 5 + 4]; return true;
    }
};
struct Moe1Sched {
    static constexpr bool GATHER = true, HALFABLE = true;
    MoeOrder mo; const bf16_t* HN; const bf16_t* W13; const int* TL;
    __device__ __forceinline__ bool next(int i, pg8::Unit& u) const { return mo.next(i, u); }
    __device__ __forceinline__ int kdim(const pg8::Unit&) const { return D; }
    __device__ __forceinline__ const char* a_base(const pg8::Unit&) const { return (const char*)HN; }
    __device__ __forceinline__ const char* b_base(const pg8::Unit& u) const { return (const char*)W13 + ((size_t)u.aux * 1024 + (size_t)u.pn * 256) * D * 2; }
    __device__ __forceinline__ unsigned a_row_off(const pg8::Unit& u, int r) const { const int idx = 256 * u.pm + r; const int ts = TL[u.aux * CAP + (r < u.rows ? idx : 0)]; return (unsigned)(ts >> 1) * (unsigned)(D * 2); }
};
struct EpiMoe1 {         static constexpr bool STORES16 = false;
    const int* TL; const float* RSTD; bf16_t* HID;
    __device__ __forceinline__ bool operator()(f32x4 (&acc)[2][2][4][2], const pg8::Unit& u, int wr, int wc, int fr, int fq) const {
        const int cl = 128 * u.pn + wc * 32 + 8 * fq;
#pragma unroll
        for (int ai = 0; ai < 2; ++ai)
#pragma unroll
            for (int m = 0; m < 4; ++m) { const int rl = ai * 128 + wr * 64 + m * 16 + fr;
                if (rl < u.rows) { const float rs = RSTD[TL[u.aux * CAP + 256 * u.pm + rl] >> 1]; float v[8];
#pragma unroll
                    for (int j = 0; j < 4; ++j) { const float a0 = acc[ai][0][m][0][j] * rs, b0 = acc[ai][1][m][0][j] * rs, a1 = acc[ai][0][m][1][j] * rs, b1 = acc[ai][1][m][1][j] * rs;
                        v[j] = a0 * sigm(a0) * b0; v[4 + j] = a1 * sigm(a1) * b1; }
                    u32x4 w; w.x = cvt_pk_bf16(v[0], v[1]); w.y = cvt_pk_bf16(v[2], v[3]); w.z = cvt_pk_bf16(v[4], v[5]); w.w = cvt_pk_bf16(v[6], v[7]);
                    *(u32x4*)(HID + (size_t)(u.base + rl) * FF + cl) = w; } }
        return true;
    }
};
struct Moe2Sched {
    static constexpr bool GATHER = false, HALFABLE = true;
    MoeOrder mo; const bf16_t* HID; const bf16_t* W2;
    __device__ __forceinline__ bool next(int i, pg8::Unit& u) const { return mo.next(i, u); }
    __device__ __forceinline__ int kdim(const pg8::Unit&) const { return FF; }
    __device__ __forceinline__ const char* a_base(const pg8::Unit& u) const { return (const char*)HID + (size_t)u.base * FF * 2; }
    __device__ __forceinline__ const char* b_base(const pg8::Unit& u) const { return (const char*)W2 + ((size_t)u.aux * D + (size_t)u.pn * 256) * FF * 2; }
};
struct EpiMoe2 {         static constexpr bool STORES16 = false;
    bf16_t* YC;
    __device__ __forceinline__ bool operator()(f32x4 (&acc)[2][2][4][2], const pg8::Unit& u, int wr, int wc, int fr, int fq) const {
        const int col0 = u.pn * 256 + wc * 32 + 8 * fq;
#pragma unroll
        for (int ai = 0; ai < 2; ++ai)
#pragma unroll
            for (int m = 0; m < 4; ++m) { const int rl = ai * 128 + wr * 64 + m * 16 + fr;
                if (rl < u.rows) { bf16_t* dst = YC + (size_t)(u.base + rl) * D + col0;
#pragma unroll
                    for (int bj = 0; bj < 2; ++bj) { u32x4 w; w.x = cvt_pk_bf16(acc[ai][bj][m][0][0], acc[ai][bj][m][0][1]); w.y = cvt_pk_bf16(acc[ai][bj][m][0][2], acc[ai][bj][m][0][3]);
                        w.z = cvt_pk_bf16(acc[ai][bj][m][1][0], acc[ai][bj][m][1][1]); w.w = cvt_pk_bf16(acc[ai][bj][m][1][2], acc[ai][bj][m][1][3]);
                        *(u32x4*)(dst + bj * 128) = w; } } }
        return true;
    }
};

template <bool DRY> __device__ __forceinline__ void p10_final(Frame& F) {
    LAS int* RO = (LAS int*)(F.lds + MISC_OFF + 256) + 40; LAS int* CN = RO + 40;
    if (F.tid < NE) { int n = (int)__hip_atomic_load(F.ctl + CW_CNT + 64 * F.tid, __ATOMIC_RELAXED, __HIP_MEMORY_SCOPE_AGENT); CN[F.tid] = n > CAP ? CAP : n; }
    __syncthreads();
    if (F.tid == 0) { int ro = 0; for (int e = 0; e < NE; ++e) { RO[e] = ro; ro += CN[e]; } }
    __syncthreads();
    const int gw = F.vcu * 8 + F.wave, NGW = F.G * 8; const bf16_t* YC = WSP(bf16_t, WS_YS); const bf16_t* HM = WSP(bf16_t, WS_HM);
    f32x4 gg[8];
#pragma unroll
    for (int j = 0; j < 8; ++j) gg[j] = ((const f32x4*)F.in[16])[F.lane + 64 * j];
    const int* SP = WSP(int, WS_SP); const float* SW = WSP(float, WS_SW);
    for (int m = gw; m < T; m += NGW) {
        const int s0 = SP[2 * m], s1 = SP[2 * m + 1]; const float w0 = SW[2 * m], w1 = SW[2 * m + 1];
        const int r0 = RO[(s0 >> 16) & 31] + (s0 & 0xffff), r1 = RO[(s1 >> 16) & 31] + (s1 & 0xffff);
        const f32x4* xr = (const f32x4*)(F.in[0] + (size_t)m * D) + F.lane; const u32x2* hm = (const u32x2*)(HM + (size_t)m * D) + F.lane;
        const u32x2* y0 = (const u32x2*)(YC + (size_t)(r0 & 16383) * D) + F.lane; const u32x2* y1 = (const u32x2*)(YC + (size_t)(r1 & 16383) * D) + F.lane;
        f32x4 v[8]; float s = 0.f;
#pragma unroll
        for (int j = 0; j < 8; ++j) { v[j] = xr[64 * j]; const u32x2 h = hm[64 * j], a = y0[64 * j], b = y1[64 * j];
            v[j].x = ((v[j].x + bf_lo(h.x)) + w0 * bf_lo(a.x)) + w1 * bf_lo(b.x); v[j].y = ((v[j].y + bf_hi(h.x)) + w0 * bf_hi(a.x)) + w1 * bf_hi(b.x);
            v[j].z = ((v[j].z + bf_lo(h.y)) + w0 * bf_lo(a.y)) + w1 * bf_lo(b.y); v[j].w = ((v[j].w + bf_hi(h.y)) + w0 * bf_hi(a.y)) + w1 * bf_hi(b.y);
            s += (v[j].x * v[j].x + v[j].y * v[j].y) + (v[j].z * v[j].z + v[j].w * v[j].w); }
        const float rstd = __builtin_amdgcn_rsqf(wave_sum(s) * (1.f / D) + EPS);
        f32x4* orow = (DRY ? (f32x4*)(WSP(float, WS_W13) + (size_t)m * D) : (f32x4*)(F.out + (size_t)m * D)) + F.lane;
#pragma unroll
        for (int j = 0; j < 8; ++j) orow[64 * j] = v[j] * rstd * gg[j];
    }
}

__device__ __forceinline__ void ph0(Frame& F, int) { p0_prologue(F); __syncthreads(); }
__device__ __forceinline__ void ph1(Frame& F, int pass) {
    const int bx = (int)blockIdx.x, grp = bx >> 3; const bool split = (F.G == 256);
    const bool conv_only = split && (grp == 10 || grp == 20 || grp == 30);
    const int nbelow = (grp > 10 ? 1 : 0) + (grp > 20 ? 1 : 0) + (grp > 30 ? 1 : 0);
    dense_units(F, T, NIN, split ? 232 : F.G, split ? (conv_only ? -1 : bx - 8 * nbelow) : bx);
    DenseSched S; S.A = WSP(bf16_t, WS_XN); S.Bt = WSP(bf16_t, WS_WIN); S.K = D; S.so.UD = (LAS int*)(F.lds + MISC_OFF + 1024);
    EpiInProj E{F.ws, F.in[3], F.in[4]};
    pg8::gemm_phase(F.lds, S, E);
    if (pass) p1_queue(F, 1 << 30);
}
__device__ __forceinline__ void ph2(Frame& F, int) {
    attn_phase<true>(F);
    { HgTile t; if (F.vcu < BH * NCH) hg_load<false>(F, F.vcu, t);
      for (int u = F.vcu; u < BH * NCH; u += F.G) hgrn_local_unit(F, u, t, u + F.G); }
}
__device__ __forceinline__ void ph3(Frame& F, int pass) {
    if (pass) hgrn_scan<false>(F); else hgrn_scan<true>(F);
    attn_phase<false>(F);
}
__device__ __forceinline__ void ph4(Frame& F, int) { HgTile t; if (F.vcu < BH * NCH) hg_load<true>(F, F.vcu, t);
    for (int u = F.vcu; u < BH * NCH; u += F.G) hgrn_out_unit(F, u, t, u + F.G); }
__device__ __forceinline__ void ph5(Frame& F, int) {
    dense_units(F, T, D, F.G, (int)blockIdx.x);
    MergedSched S; S.OA = WSP(bf16_t, WS_OA); S.WA = WSP(bf16_t, WS_WA); S.OB = WSP(bf16_t, WS_OB); S.WB = WSP(bf16_t, WS_WB); S.so.UD = (LAS int*)(F.lds + MISC_OFF + 1024);
    EpiMerged E{WSP(bf16_t, WS_GA), WSP(bf16_t, WS_GBT), WSP(bf16_t, WS_MERGED)};
    pg8::gemm_phase(F.lds, S, E);
}
__device__ __forceinline__ void ph6(Frame& F, int) {
    dense_units(F, T, D, F.G, (int)blockIdx.x);
    DenseSched S; S.A = WSP(bf16_t, WS_MERGED); S.Bt = WSP(bf16_t, WS_WOUT); S.K = D; S.so.UD = (LAS int*)(F.lds + MISC_OFF + 1024);
    EpiResid E{WSP(bf16_t, WS_HM)};
    pg8::gemm_phase(F.lds, S, E);
}
__device__ __forceinline__ void ph7(Frame& F, int pass) { if (pass) p7_router<false>(F); else p7_router<true>(F); }
__device__ __forceinline__ void ph8(Frame& F, int pass) {
    moe_tables<4>(F);
    LAS int* TP = (LAS int*)(F.lds + MISC_OFF + 256);
    Moe1Sched S; S.mo.UL = TP + 120; S.HN = WSP(bf16_t, WS_XN); S.W13 = WSP(bf16_t, WS_W13); S.TL = WSP(int, WS_TOKL);
    EpiMoe1 E{WSP(int, WS_TOKL), WSP(float, WS_RSTD), WSP(bf16_t, WS_HID)};
    pg8::gemm_phase(F.lds, S, E);
    if (pass) { const int nu = TP[NE] * 4, rem = nu % F.G;
        if (rem == 0) p8_filler(F, F.vcu, F.G); else if (F.vcu >= rem) p8_filler(F, F.vcu - rem, F.G - rem); }
}
__device__ __forceinline__ void ph9(Frame& F, int) {
    moe_tables<8>(F);
    LAS int* TP = (LAS int*)(F.lds + MISC_OFF + 256);
    Moe2Sched S; S.mo.UL = TP + 120; S.HID = WSP(bf16_t, WS_HID); S.W2 = WSP(bf16_t, WS_W2);
    EpiMoe2 E{WSP(bf16_t, WS_YS)};
    pg8::gemm_phase(F.lds, S, E);
}
__device__ __forceinline__ void ph10(Frame& F, int pass) { if (pass) p10_final<false>(F); else p10_final<true>(F); }

constexpr int N_PHASES = 11;
struct Args { const float* in[17]; float* out; unsigned char* ws; int ph_lo, ph_hi; };
__global__ void __launch_bounds__(512, 2) fwd_kernel(Args args) {
    extern __shared__ __attribute__((aligned(16))) unsigned char lds_raw[];
    Frame F;
    F.lds = (LAS unsigned char*)lds_raw;
    F.tid = threadIdx.x; F.lane = F.tid & 63; F.wave = __builtin_amdgcn_readfirstlane(F.tid >> 6);
    F.G = gridDim.x; { const int bx = blockIdx.x; F.vcu = (F.G % 8 == 0) ? (bx % 8) * (F.G / 8) + bx / 8 : bx; }
    F.ws = args.ws; F.ctl = (unsigned*)(args.ws + WS_CTL); F.out = args.out;
#pragma unroll
    for (int i = 0; i < 17; ++i) F.in[i] = args.in[i];
    volatile LAS unsigned* MISC = (volatile LAS unsigned*)(F.lds + MISC_OFF);
    if (F.tid < 64) MISC[F.tid] = 0u;
    __syncthreads();
#if MK_PER_PHASE
#define GRID_BAR() do { } while (0)
#else
    XcdBarrier bar = xcd_barrier_post(F.ctl + CW_BAR, MISC + 8);
#define GRID_BAR() xcd_barrier(bar)
#endif
    const int lo = args.ph_lo, hi = args.ph_hi;
#define IN(k) (lo <= (k) && (k) < hi)
#define SEAM(k) do { if (IN(k) && IN((k) + 1)) GRID_BAR(); } while (0)
#define RUN(k, f) do { if (IN(k)) { if (PROBE_REPEAT == (k)) { f(F, 0); if ((k) == 7) { GRID_BAR(); } } f(F, 1); } } while (0)

    RUN(0, ph0);  SEAM(0);
    if (PROBE_REPEAT == 20) { for (int xb = 0; xb < 10; ++xb) GRID_BAR(); }
    RUN(1, ph1);  SEAM(1);
    RUN(2, ph2);  SEAM(2);
    RUN(3, ph3);  SEAM(3);
    RUN(4, ph4);  SEAM(4);
    RUN(5, ph5);  SEAM(5);
    RUN(6, ph6);  SEAM(6);
    RUN(7, ph7);  SEAM(7);
    RUN(8, ph8);  SEAM(8);
    RUN(9, ph9);  SEAM(9);
    RUN(10, ph10);
#undef IN
#undef SEAM
}

extern "C" void kernel_launch(void* const* d_in, const int* in_sizes, int n_in, void* d_out, int out_size, void* d_ws, size_t ws_size, hipStream_t stream) {
    static int grid = 0;
    if (grid == 0) {
        if (n_in != 17 || out_size != T * D || ws_size < WS_END) { fprintf(stderr, "kernel_launch: unexpected shapes (n_in %d, out %d, ws %zu < %zu)\n", n_in, out_size, ws_size, (size_t)WS_END); grid = -1; return; }
        int dev = 0, cus = 0, per_cu = 0;
        if (hipGetDevice(&dev) != hipSuccess || hipDeviceGetAttribute(&cus, hipDeviceAttributeMultiprocessorCount, dev) != hipSuccess) { grid = -1; return; }
        if (hipFuncSetAttribute((const void*)fwd_kernel, hipFuncAttributeMaxDynamicSharedMemorySize, LDS_BYTES) != hipSuccess) { fprintf(stderr, "kernel_launch: hipFuncSetAttribute failed\n"); grid = -1; return; }
        if (hipOccupancyMaxActiveBlocksPerMultiprocessor(&per_cu, (const void*)fwd_kernel, 512, LDS_BYTES) != hipSuccess || per_cu < 1) { fprintf(stderr, "kernel_launch: occupancy query says %d blocks per CU\n", per_cu); }
        (void)hipGetLastError();
        grid = cus;
    }
    if (grid < 0) return;
    (void)in_sizes;
    if (hipMemsetAsync((char*)d_ws + WS_CTL, 0, CTL_ZERO_BYTES, stream) != hipSuccess) return;
    Args a{};
    for (int i = 0; i < 17; ++i) a.in[i] = (const float*)d_in[i];
    a.out = (float*)d_out; a.ws = (unsigned char*)d_ws;
#if MK_PER_PHASE
    for (int p = 0; p < N_PHASES; ++p) { a.ph_lo = p; a.ph_hi = p + 1; hipLaunchKernelGGL(fwd_kernel, dim3(grid), dim3(512), LDS_BYTES, stream, a); }
#else
    a.ph_lo = 0; a.ph_hi = N_PHASES; hipLaunchKernelGGL(fwd_kernel, dim3(grid), dim3(512), LDS_BYTES, stream, a);
#endif
}
```

```cpp
#include <hip/hip_runtime.h>
#include <cstdio>
#include <cstdint>

#ifndef MK_PER_PHASE
#define MK_PER_PHASE 0
#endif
#ifndef PROBE_REPEAT
#define PROBE_REPEAT -1
#endif

#define LAS __attribute__((address_space(3)))
#define GAS __attribute__((address_space(1)))
typedef unsigned short bf16_t;
typedef short bf16x8 __attribute__((ext_vector_type(8)));
typedef short s16x4 __attribute__((ext_vector_type(4)));
typedef float f32x4 __attribute__((ext_vector_type(4)));
typedef float f32x2 __attribute__((ext_vector_type(2)));
typedef unsigned u32x4 __attribute__((ext_vector_type(4)));
typedef unsigned u32x2 __attribute__((ext_vector_type(2)));

constexpr int T = 8192, D = 2048, NIN = 12800;
constexpr int AH = 12, AW = 1536;
constexpr int BH = 8, BW = 1024, NCH = 128;
constexpr int NE = 32, FF = 512, CAP = 8192;
constexpr float EPS = 1e-6f;
constexpr float LOG2E = 1.4426950408889634f, LN2 = 0.6931471805599453f;
constexpr float QSCALE = 0.08838834764831845f * 1.4426950408889634f;

constexpr size_t MiB = 1u << 20;
constexpr size_t WS_CTL = 0, CTL_ZERO_BYTES = 1 * MiB;
constexpr size_t WS_WIN = 1 * MiB;
constexpr size_t WS_O1 = WS_WIN, WS_O4 = WS_WIN + 24 * MiB;
constexpr size_t WS_WA = 51 * MiB;
constexpr size_t WS_WB = 57 * MiB;
constexpr size_t WS_WOUT = 61 * MiB;
constexpr size_t WS_XN = 69 * MiB;
constexpr size_t WS_QA = 101 * MiB, WS_KA = 125 * MiB, WS_VA = 149 * MiB;
constexpr size_t WS_W2 = WS_QA;
constexpr size_t WS_QB = 173 * MiB;
constexpr size_t WS_LOGF = 189 * MiB;
constexpr size_t WS_HM = 173 * MiB;
constexpr size_t WS_IB = 221 * MiB;
constexpr size_t WS_GB = 237 * MiB;
constexpr size_t WS_GA = 253 * MiB;
constexpr size_t WS_GBT = 285 * MiB;
constexpr size_t WS_ST = 317 * MiB;
constexpr size_t WS_MERGED = WS_ST, WS_YS = WS_ST;
constexpr size_t WS_OA = 381 * MiB;
constexpr size_t WS_HID = WS_OA;
constexpr size_t WS_OB = 405 * MiB;
constexpr size_t WS_W13 = 421 * MiB;
constexpr size_t WS_DEC = 549 * MiB;
constexpr size_t WS_LSE1 = WS_DEC + 512 * 1024, WS_LSE4 = WS_LSE1 + 384 * 1024;
constexpr size_t WS_RSTD = WS_LSE4 + 384 * 1024;
constexpr size_t WS_TOKL = 550 * MiB + 512 * 1024;
constexpr size_t WS_TOKW = WS_TOKL + 1 * MiB;
constexpr size_t WS_WTR = WS_TOKW + 1 * MiB;
constexpr size_t WS_SP = WS_WTR + 512 * 1024;
constexpr size_t WS_SW = WS_SP + 64 * 1024;
constexpr size_t WS_END = 554 * MiB;
constexpr int CW_BAR = 4096;
constexpr int CW_CNT = 16384;
constexpr int CW_Q1 = 24576;

constexpr int RING_BYTES = 147456;
constexpr int MISC_OFF = RING_BYTES;
constexpr int LDS_BYTES = RING_BYTES + 4096;

typedef __bf16 bf16x2_t __attribute__((ext_vector_type(2)));
__device__ __forceinline__ unsigned cvt_pk_bf16(float lo, float hi) { bf16x2_t v; v[0] = (__bf16)lo; v[1] = (__bf16)hi; return __builtin_bit_cast(unsigned, v); }
__device__ __forceinline__ float bf_lo(unsigned w) { return __uint_as_float(w << 16); }
__device__ __forceinline__ float bf_hi(unsigned w) { return __uint_as_float(w & 0xffff0000u); }
__device__ __forceinline__ float ex2(float x) { return __builtin_amdgcn_exp2f(x); }
__device__ __forceinline__ float expn(float x) { return __builtin_amdgcn_exp2f(x * LOG2E); }
__device__ __forceinline__ float lg2(float x) { return __builtin_amdgcn_logf(x); }
__device__ __forceinline__ float sigm(float x) { return __builtin_amdgcn_rcpf(1.0f + __builtin_amdgcn_exp2f(-x * LOG2E)); }
__device__ __forceinline__ float wave_sum(float v) {
#pragma unroll
    for (int o = 1; o < 64; o <<= 1) v += __shfl_xor(v, o);
    return v;
}
#define LDS_WAIT() asm volatile("s_waitcnt lgkmcnt(0)" ::: "memory")
#define VM_WAIT() asm volatile("s_waitcnt vmcnt(0)" ::: "memory")

#define XB_TMO      128
#define XB_XCNT(j)  (256  + 64 * (j))
#define XB_XSUB(j)  (1280 + 64 * (j))
#define XB_XGEN(j)  (2304 + 64 * (j))
#define XB_TOP      3328
#define XB_TOPGEN   3392
#define XCD_BAR_WORDS 3456
#define XB_SPIN_CAP (1u << 18)
__device__ __forceinline__ unsigned xb_ld(unsigned* p)              { return __hip_atomic_load(p, __ATOMIC_RELAXED, __HIP_MEMORY_SCOPE_AGENT); }
__device__ __forceinline__ unsigned xb_add(unsigned* p, unsigned v) { return __hip_atomic_fetch_add(p, v, __ATOMIC_RELAXED, __HIP_MEMORY_SCOPE_AGENT); }
__device__ __forceinline__ unsigned xb_xcc_id() { return (unsigned)__builtin_amdgcn_s_getreg((3 << 11) | 20) & 0xFu; }
#define XB_SPIN(cond, bar) do { unsigned _sp = 0; while (cond) { __builtin_amdgcn_s_sleep(1); \
    if ((++_sp & 255u) == 0u) { if (xb_ld(&(bar)[XB_TMO])) break; if (_sp > XB_SPIN_CAP) { atomicAdd(&(bar)[XB_TMO], 1u); break; } } } } while (0)
struct XcdBarrier { unsigned* bar; unsigned x; volatile LAS unsigned* st; };
__device__ __forceinline__ XcdBarrier xcd_barrier_post(unsigned* bar, volatile LAS unsigned* st) {
    XcdBarrier b; b.bar = bar; b.x = xb_xcc_id(); b.st = st;
    if (threadIdx.x == 0) (void)xb_add(&bar[XB_XCNT(b.x)], 1u);
    return b;
}
__device__ __forceinline__ void xcd_barrier_complete(unsigned* bar, unsigned x, unsigned& nloc, unsigned& nx) {
    const unsigned G = gridDim.x * gridDim.y * gridDim.z;
    unsigned sum, cnt, mine, sp = 0u;
    for (;;) {
        sum = 0u; cnt = 0u; mine = 0u;
#pragma unroll
        for (unsigned j = 0; j < 16; ++j) { const unsigned c = xb_ld(&bar[XB_XCNT(j)]); sum += c; cnt += (c > 0u) ? 1u : 0u; mine = (j == x) ? c : mine; }
        if (sum == G) break;
        __builtin_amdgcn_s_sleep(1);
        if ((++sp & 255u) == 0u) { if (xb_ld(&bar[XB_TMO])) break; if (sp > XB_SPIN_CAP) { atomicAdd(&bar[XB_TMO], 1u); break; } }
    }
    nloc = mine > 0u ? mine : 1u; nx = cnt > 0u ? cnt : 1u;
}
__device__ __forceinline__ void xcd_barrier(const XcdBarrier& b) {
    asm volatile("s_waitcnt vmcnt(0)" ::: "memory");
    __syncthreads();
    if (threadIdx.x == 0) {
        unsigned* bar = b.bar;
        __builtin_amdgcn_s_waitcnt(0);
        unsigned nloc = b.st[0], nx = b.st[1];
        if (nloc == 0u) { xcd_barrier_complete(bar, b.x, nloc, nx); b.st[0] = nloc; b.st[1] = nx; }
        const unsigned old = xb_add(&bar[XB_XSUB(b.x)], 1u);
        const unsigned gen = old / nloc;
        if (old + 1u == (gen + 1u) * nloc) {
            __builtin_amdgcn_fence(__ATOMIC_RELEASE, "agent");
            asm volatile("s_waitcnt vmcnt(0)" ::: "memory");
            const unsigned og = xb_add(&bar[XB_TOP], 1u);
            const unsigned tg = og / nx;
            if (og + 1u == (tg + 1u) * nx) xb_add(&bar[XB_TOPGEN], 1u);
            else XB_SPIN(xb_ld(&bar[XB_TOPGEN]) == tg, bar);
            __builtin_amdgcn_fence(__ATOMIC_ACQUIRE, "agent");
            xb_add(&bar[XB_XGEN(b.x)], 1u);
            asm volatile("s_waitcnt vmcnt(0)" ::: "memory");
        } else {
            XB_SPIN(xb_ld(&bar[XB_XGEN(b.x)]) == gen, bar);
            __builtin_amdgcn_fence(__ATOMIC_ACQUIRE, "agent");
            asm volatile("s_waitcnt vmcnt(0)" ::: "memory");
        }
    }
    __syncthreads();
}

namespace pg8 {
constexpr int BM = 256, BK = 64, HALF = 128, HTB = HALF * BK * 2, STAGE_BYTES = 8 * HTB, NXCD = 8, WGM = 8;
__host__ __device__ __forceinline__ int lds_byte(int r, int c) { const int st = (r >> 4) * 2 + (c >> 5), rr = r & 15, cc = c & 31, ob = rr * 64 + cc * 2; return st * 1024 + (ob ^ (((ob >> 9) & 1) << 5)); }
__host__ __device__ __forceinline__ void stage_rc(int b, int& R, int& C) { const int st = b / 1024, sb = b % 1024, swz = sb ^ (((sb >> 9) & 1) << 5); R = (st >> 1) * 16 + swz / 64; C = (st & 1) * 32 + (swz % 64) / 2; }
__host__ __device__ __forceinline__ int perm32(int rho) { const int n = rho >> 4, i = rho & 15; return 8 * (i >> 2) + 4 * n + (i & 3); }

struct Unit { int pm, pn, aux, rows, base; };

struct StaticOrder {
    int nM, nN, nwg, G, c;
    __device__ void init(int M, int N, int G_, int c_) { nM = M / BM; nN = N / BM; nwg = nM * nN; G = G_; c = c_; }
    __device__ bool next(int i, Unit& u) const {
        const long L = (long)i * G + c; if (L >= nwg) return false;
        int wgid = (int)L; { const int q = nwg / NXCD, r = nwg % NXCD, xcd = wgid % NXCD, off = wgid / NXCD; wgid = (xcd < r ? xcd * (q + 1) : r * (q + 1) + (xcd - r) * q) + off; }
        const int nig = WGM * nN, gid = wgid / nig, fm = gid * WGM, gsz = (nM - fm) < WGM ? (nM - fm) : WGM;
        u.pm = fm + ((wgid % nig) % gsz); u.pn = (wgid % nig) / gsz; u.aux = 0; u.rows = 256; u.base = 0; return true;
    }
};

template <bool GATHER> struct Ops { const char* A; const char* B; int K; unsigned oB; unsigned oA[GATHER ? 4 : 1]; };

template <class Sched> __device__ __forceinline__ void ops_setup(const Sched& S, const Unit& u, int R0, int Rb0, int C0, Ops<Sched::GATHER>& o) {
    o.K = S.kdim(u); o.A = S.a_base(u); o.B = S.b_base(u);
    o.oB = (unsigned)(Rb0 * o.K + C0) * 2u;
    if constexpr (Sched::GATHER) {
#pragma unroll
        for (int q = 0; q < 4; ++q) o.oA[q] = S.a_row_off(u, R0 + 64 * q) + (unsigned)C0 * 2u;
    } else o.oA[0] = (unsigned)(R0 * o.K + C0) * 2u;
}
template <bool GATHER> __device__ __forceinline__ void stage_a(LAS unsigned char* dst, const Ops<GATHER>& o, int h, size_t koff) {
#pragma unroll
    for (int i = 0; i < 2; ++i) {
        const char* src;
        if constexpr (GATHER) src = o.A + koff + o.oA[h * 2 + i];
        else src = o.A + (koff + (size_t)(h * 128 + i * 64) * (size_t)o.K * 2) + o.oA[0];
        __builtin_amdgcn_global_load_lds((const unsigned*)src, (LAS unsigned*)(dst + i * 8192), 16, 0, 0);
    }
}
template <bool GATHER> __device__ __forceinline__ void stage_b(LAS unsigned char* dst, const Ops<GATHER>& o, int h, size_t koff) {
#pragma unroll
    for (int i = 0; i < 2; ++i) {
        const char* src = o.B + (koff + (size_t)(h * 128 + i * 64) * (size_t)o.K * 2) + o.oB;
        __builtin_amdgcn_global_load_lds((const unsigned*)src, (LAS unsigned*)(dst + i * 8192), 16, 0, 0);
    }
}

template <class Epi, class Sched>
__device__ __forceinline__ void gemm_phase(LAS unsigned char* lds, const Sched& S, const Epi& E) {
    constexpr bool GA_ = Sched::GATHER;
    const int tid = threadIdx.x, wid = __builtin_amdgcn_readfirstlane(tid >> 6), lane = tid & 63, wr = wid >> 2, wc = wid & 3, fr = lane & 15, fq = lane >> 4;
    int R0, C0; stage_rc(tid * 16, R0, C0);
    const int Rb0 = (R0 & ~31) + perm32(R0 & 31);
    const size_t kstep = (size_t)(BK * 2);
    const unsigned ldsw = (unsigned)wid * 1024u;
    const int aoff = lds_byte(wr * 64 + fr, fq * 8), boff = lds_byte(wc * 32 + fr, fq * 8);
#define PG8_SA(b, h) (((b) * 2 + (h)) * HTB)
#define PG8_SB(b, h) ((4 + (b) * 2 + (h)) * HTB)
#define PG8_STA(b, h, O, koff) stage_a<GA_>(lds + PG8_SA(b, h) + ldsw, O, h, koff)
#define PG8_STB(b, h, O, koff) stage_b<GA_>(lds + PG8_SB(b, h) + ldsw, O, h, koff)
#define PG8_LDA(dst, b, h) do { _Pragma("unroll") for (int m = 0; m < 4; ++m) _Pragma("unroll") for (int k = 0; k < 2; ++k) dst[m][k] = *(const LAS bf16x8*)(lds + PG8_SA(b, h) + aoff + m * 2048 + k * 1024); } while (0)
#define PG8_LDB(dst, b, h) do { _Pragma("unroll") for (int n = 0; n < 2; ++n) _Pragma("unroll") for (int k = 0; k < 2; ++k) dst[n][k] = *(const LAS bf16x8*)(lds + PG8_SB(b, h) + boff + n * 2048 + k * 1024); } while (0)
#define PG8_MMA(ai, bj, At, Bt) do { __builtin_amdgcn_s_setprio(1); _Pragma("unroll") for (int m = 0; m < 4; ++m) _Pragma("unroll") for (int n = 0; n < 2; ++n) _Pragma("unroll") for (int k = 0; k < 2; ++k) \
        acc[ai][bj][m][n] = __builtin_amdgcn_mfma_f32_16x16x32_bf16(Bt[n][k], At[m][k], acc[ai][bj][m][n], 0, 0, 0); __builtin_amdgcn_s_setprio(0); } while (0)
#define PG8_WAIT_V(n) asm volatile("s_waitcnt vmcnt(" #n ")" ::: "memory")
#define PG8_WAIT_L(n) asm volatile("s_waitcnt lgkmcnt(" #n ")" ::: "memory")
#define PG8_BAR __builtin_amdgcn_s_barrier()
#define PG8_SCHED __builtin_amdgcn_sched_barrier(0)
    Unit cur, nxt; int ui = 0;
    if (!S.next(0, cur)) return;
    f32x4 acc[2][2][4][2];
#pragma unroll
    for (int a = 0; a < 2; ++a)
#pragma unroll
        for (int b = 0; b < 2; ++b)
#pragma unroll
            for (int m = 0; m < 4; ++m)
#pragma unroll
                for (int n = 0; n < 2; ++n) acc[a][b][m][n] = (f32x4){0.f, 0.f, 0.f, 0.f};
    bf16x8 At[4][2], B0[2][2], B1[2][2];
    Ops<GA_> oc, op;
    ops_setup(S, cur, R0, Rb0, C0, oc); op = oc;
    PG8_STB(0, 0, oc, 0); PG8_STB(0, 1, oc, 0); PG8_STA(0, 0, oc, 0); PG8_STA(0, 1, oc, 0);
    if (wr == 1) PG8_BAR;
    PG8_WAIT_V(2); PG8_BAR;
    PG8_STB(1, 0, oc, kstep); PG8_STA(1, 0, oc, kstep); PG8_STB(1, 1, oc, kstep);
    PG8_WAIT_V(6); PG8_BAR;
    for (;;) {
        const bool has_next = S.next(ui + 1, nxt);
        const int nt = oc.K / BK;
        const bool full = !Sched::HALFABLE || cur.rows > 128;
#define PG8_ITER(W) do { \
            const bool last = (t == nt - 2); \
            const size_t k1 = (size_t)(t + 1) * kstep; \
            if (last && has_next) ops_setup(S, nxt, R0, Rb0, C0, op); \
            const size_t k2 = last ? 0 : (size_t)(t + 2) * kstep, k3 = k2 + kstep; \
              \
            PG8_LDB(B0, 0, 0); PG8_LDB(B1, 0, 1); PG8_SCHED; PG8_LDA(At, 0, 0); PG8_STA(1, 1, oc, k1); \
            PG8_WAIT_V(W); PG8_WAIT_L(0); PG8_BAR; PG8_MMA(0, 0, At, B0); PG8_MMA(0, 1, At, B1); PG8_BAR; PG8_SCHED; \
              \
            PG8_LDA(At, 0, 1); PG8_STB(0, 0, op, k2); PG8_STB(0, 1, op, k2); PG8_STA(0, 0, op, k2); \
            PG8_WAIT_V(W); PG8_WAIT_L(0); PG8_BAR; if (full) { PG8_MMA(1, 0, At, B0); PG8_MMA(1, 1, At, B1); } PG8_BAR; PG8_SCHED; \
              \
            PG8_LDB(B0, 1, 0); PG8_LDB(B1, 1, 1); PG8_SCHED; PG8_LDA(At, 1, 0); PG8_STA(0, 1, op, k2); \
            PG8_WAIT_V(8); PG8_WAIT_L(0); PG8_BAR; PG8_MMA(0, 0, At, B0); PG8_MMA(0, 1, At, B1); PG8_BAR; PG8_SCHED; \
              \
            PG8_LDA(At, 1, 1); PG8_STB(1, 0, op, k3); PG8_STB(1, 1, op, k3); PG8_STA(1, 0, op, k3); \
            PG8_WAIT_V(8); PG8_WAIT_L(0); PG8_BAR; if (full) { PG8_MMA(1, 0, At, B0); PG8_MMA(1, 1, At, B1); } PG8_BAR; PG8_SCHED; \
        } while (0)
        int t = 0;
        if (Epi::STORES16 && ui > 0) { PG8_ITER(24); t = 2; }
        for (; t < nt; t += 2) PG8_ITER(8);
#undef PG8_ITER
        if (wr == 0) PG8_BAR;
        const bool reset = E(acc, cur, wr, wc, fr, fq);
        if (!has_next) break;
        if (reset) {
#pragma unroll
            for (int a = 0; a < 2; ++a)
#pragma unroll
                for (int b = 0; b < 2; ++b)
#pragma unroll
                    for (int m = 0; m < 4; ++m)
#pragma unroll
                        for (int n = 0; n < 2; ++n) acc[a][b][m][n] = (f32x4){0.f, 0.f, 0.f, 0.f};
        }
        cur = nxt; oc = op; ++ui;
        if (wr == 1) PG8_BAR;
    }
    PG8_WAIT_V(0);
    PG8_BAR;
#undef PG8_SA
#undef PG8_SB
#undef PG8_STA
#undef PG8_STB
#undef PG8_LDA
#undef PG8_LDB
#undef PG8_MMA
#undef PG8_WAIT_V
#undef PG8_WAIT_L
#undef PG8_BAR
#undef PG8_SCHED
}
}

struct Frame {
    LAS unsigned char* lds;
    unsigned* ctl;
    int tid, lane, wave, vcu, G;
    const float* in[17];
    float* out;
    unsigned char* ws;
};
#define WSP(type, off) ((type*)(F.ws + (off)))

constexpr int TSCR = 64 * 65 * 4;
template <bool NT> __device__ __forceinline__ void tr64_load(f32x4 (&v)[16], const float* W, int ldw, int k0, int n0, int lane, const float* gk = nullptr) {
    const int r4 = lane >> 4, c4 = lane & 15;
#pragma unroll
    for (int it = 0; it < 16; ++it) { const f32x4* src = (const f32x4*)(W + (size_t)(k0 + 4 * it + r4) * ldw + n0 + 4 * c4); v[it] = NT ? __builtin_nontemporal_load(src) : *src; }
    if (gk) { const float gl = gk[k0 + lane];
#pragma unroll
        for (int it = 0; it < 16; ++it) v[it] = v[it] * __shfl(gl, 4 * it + r4); }
}
template <bool NT> __device__ __forceinline__ void tr64_finish(const f32x4 (&v)[16], int k0, bf16_t* WT, int ldt, int drow0, LAS float* scr, int lane) {
    const int r4 = lane >> 4, c4 = lane & 15;
#pragma unroll
    for (int it = 0; it < 16; ++it) { LAS float* d = scr + (4 * it + r4) * 65 + 4 * c4; d[0] = v[it].x; d[1] = v[it].y; d[2] = v[it].z; d[3] = v[it].w; }
    LDS_WAIT(); asm volatile("" ::: "memory");
    const int c = lane & 7;
#pragma unroll
    for (int j = 0; j < 8; ++j) { const int n = (lane >> 3) + 8 * j; const LAS float* q = scr + (8 * c) * 65 + n;
        u32x4 o; o.x = cvt_pk_bf16(q[0 * 65], q[1 * 65]); o.y = cvt_pk_bf16(q[2 * 65], q[3 * 65]); o.z = cvt_pk_bf16(q[4 * 65], q[5 * 65]); o.w = cvt_pk_bf16(q[6 * 65], q[7 * 65]);
        u32x4* dst = (u32x4*)(WT + (size_t)(drow0 + n) * ldt + k0 + 8 * c); if (NT) __builtin_nontemporal_store(o, dst); else *dst = o; }
    LDS_WAIT(); asm volatile("" ::: "memory");
}
template <bool NT = false>
__device__ __forceinline__ void transpose_item64(const float* W, int ldw, int k0, int n0, bf16_t* WT, int ldt, int drow0, LAS float* scr, int lane) {
    f32x4 v[16]; tr64_load<NT>(v, W, ldw, k0, n0, lane); tr64_finish<NT>(v, k0, WT, ldt, drow0, scr, lane);
}
__device__ __forceinline__ void rms_row_to_bf16(const float* xrow, const f32x4 (&gg)[8], bf16_t* orow, int lane) {
    const f32x4* xr = (const f32x4*)xrow + lane;
    f32x4 v[8]; float s = 0.f;
#pragma unroll
    for (int j = 0; j < 8; ++j) { v[j] = xr[64 * j]; s += (v[j].x * v[j].x + v[j].y * v[j].y) + (v[j].z * v[j].z + v[j].w * v[j].w); }
    const float rstd = __builtin_amdgcn_rsqf(wave_sum(s) * (1.f / D) + EPS);
    u32x2* o8 = (u32x2*)orow + lane;
#pragma unroll
    for (int j = 0; j < 8; ++j) { u32x2 w; w.x = cvt_pk_bf16(v[j].x * rstd * gg[j].x, v[j].y * rstd * gg[j].y); w.y = cvt_pk_bf16(v[j].z * rstd * gg[j].z, v[j].w * rstd * gg[j].w); o8[64 * j] = w; }
}
constexpr int E0 = 0;
template <bool NT = false> __device__ __forceinline__ void w13_item(Frame& F, int r, LAS float* scr) {
    const int w3 = r >= 32 * 256 ? 1 : 0; if (w3) r -= 32 * 256;
    const int e = r >> 8, r2 = r & 255, kb = r2 >> 3, nb = r2 & 7, n0 = 64 * nb;
    const int drow0 = 256 * (n0 >> 7) + (n0 & 127) + 128 * w3;
    transpose_item64<NT>((w3 ? F.in[14] : F.in[13]) + (size_t)e * D * FF, FF, 64 * kb, n0, WSP(bf16_t, WS_W13) + (size_t)e * 1024 * D, D, drow0, scr, F.lane);
}
__device__ __forceinline__ void p0_prologue(Frame& F) {
    LAS float* scr = (LAS float*)(F.lds + F.wave * TSCR);
    const int gw = F.vcu * 8 + F.wave, NGW = F.G * 8;
    constexpr int I_IN = 32 * 200, I_E = E0 * 256;
    constexpr int NITEMS = I_IN + 2 * I_E;
    for (int it = gw; it < NITEMS; it += NGW) {
        int r = it;
        if (r < I_IN) { const int n0 = 64 * (r % 200); int dr = n0;
            if (n0 >= 10752) { const int gb = n0 - 10752; dr = 8704 + 256 * (gb >> 7) + 128 + (gb & 127); } else if (n0 >= 8704) { const int ga = n0 - 8704; dr = 8704 + 256 * (ga >> 7) + (ga & 127); }
            transpose_item64(F.in[2], NIN, 64 * (r / 200), n0, WSP(bf16_t, WS_WIN), D, dr, scr, F.lane); continue; } r -= I_IN;
        if (r < I_E) w13_item(F, r, scr); else w13_item(F, 32 * 256 + (r - I_E), scr);
    }
    { f32x4 gg[8];
#pragma unroll
      for (int j = 0; j < 8; ++j) gg[j] = ((const f32x4*)F.in[1])[F.lane + 64 * j];
      for (int m = gw; m < T; m += NGW) rms_row_to_bf16(F.in[0] + (size_t)m * D, gg, WSP(bf16_t, WS_XN) + (size_t)m * D, F.lane); }
    { float* wtr = WSP(float, WS_WTR);
      for (int i = F.vcu * 512 + F.tid; i < 48 * D; i += F.G * 512) { const int o = i >> 11, k = i & 2047;
          float v = 0.f; if (o < 4) v = F.in[9][k * 4 + o]; else if (o >= 16) v = F.in[11][k * 32 + (o - 16)];
          wtr[i] = v * F.in[8][k]; } }
}
constexpr int W2E0 = 32;
constexpr int P1F_ITEMS = 24 * 32 + 16 * 32 + 32 * 32 + 2 * (32 - E0) * 256 + W2E0 * 256;
static_assert(E0 == 0, "w1|w3 are converted (with ffn_norm_g folded in) by the P1 queue only");
struct TrItem { const float* W; bf16_t* WT; int ldw, ldt, k0, n0, drow0; const float* gk; };
__device__ __forceinline__ TrItem p8_item(Frame& F, int it) { const int e = it >> 8, r2 = it & 255, kb = r2 >> 5, nb = r2 & 31;
    return TrItem{F.in[15] + (size_t)e * FF * D, (bf16_t*)F.out + (size_t)e * D * FF, D, FF, 64 * kb, 64 * nb, 64 * nb, nullptr}; }
__device__ __forceinline__ TrItem p1_item(Frame& F, int r) {
    constexpr int I_A = 24 * 32, I_B = 16 * 32, I_O = 32 * 32, I_E = (32 - E0) * 256;
    if (r < I_A) return TrItem{F.in[5], WSP(bf16_t, WS_WA), D, AW, 64 * (r >> 5), 64 * (r & 31), 64 * (r & 31), nullptr}; r -= I_A;
    if (r < I_B) return TrItem{F.in[6], WSP(bf16_t, WS_WB), D, BW, 64 * (r >> 5), 64 * (r & 31), 64 * (r & 31), nullptr}; r -= I_B;
    if (r < I_O) return TrItem{F.in[7], WSP(bf16_t, WS_WOUT), D, D, 64 * (r >> 5), 64 * (r & 31), 64 * (r & 31), nullptr}; r -= I_O;
    if (r >= 2 * I_E) return p8_item(F, r - 2 * I_E);
    const int w3 = r >= I_E ? 1 : 0; if (w3) r -= I_E; r += E0 * 256;
    const int e = r >> 8, r2 = r & 255, kb = r2 >> 3, nb = r2 & 7, n0 = 64 * nb;
    return TrItem{(w3 ? F.in[14] : F.in[13]) + (size_t)e * D * FF, WSP(bf16_t, WS_W13) + (size_t)e * 1024 * D, FF, D, 64 * kb, n0, 256 * (n0 >> 7) + (n0 & 127) + 128 * w3, F.in[8]};
}
__device__ __forceinline__ int q_ticket4(unsigned* q, int lane) { unsigned t = 0; if (lane == 0) t = __hip_atomic_fetch_add(q, 4u, __ATOMIC_RELAXED, __HIP_MEMORY_SCOPE_AGENT); return (int)__builtin_amdgcn_readfirstlane(t); }
__device__ __forceinline__ void p1_queue(Frame& F, int max_batches) {
    LAS float* scr = (LAS float*)(F.lds + F.wave * TSCR); unsigned* q = F.ctl + CW_Q1;
    if (max_batches <= 0) return;
    int cur = q_ticket4(q, F.lane);
    for (int nb = 0; cur < P1F_ITEMS; ++nb) { const bool lastb = (nb + 1 >= max_batches);
        const int nxt = lastb ? P1F_ITEMS : q_ticket4(q, F.lane);
        TrItem a = p1_item(F, cur), b = p1_item(F, cur + 1);
        f32x4 va[16], vb[16];
        tr64_load<true>(va, a.W, a.ldw, a.k0, a.n0, F.lane, a.gk); tr64_load<true>(vb, b.W, b.ldw, b.k0, b.n0, F.lane, b.gk);
        tr64_finish<true>(va, a.k0, a.WT, a.ldt, a.drow0, scr, F.lane);
        a = p1_item(F, cur + 2); tr64_load<true>(va, a.W, a.ldw, a.k0, a.n0, F.lane, a.gk);
        tr64_finish<true>(vb, b.k0, b.WT, b.ldt, b.drow0, scr, F.lane);
        b = p1_item(F, cur + 3); tr64_load<true>(vb, b.W, b.ldw, b.k0, b.n0, F.lane, b.gk);
        tr64_finish<true>(va, a.k0, a.WT, a.ldt, a.drow0, scr, F.lane);
        tr64_finish<true>(vb, b.k0, b.WT, b.ldt, b.drow0, scr, F.lane);
        cur = nxt;
    }
}
static_assert(P1F_ITEMS % 4 == 0, "batches of four");

__device__ __forceinline__ void dense_units(Frame& F, int M, int N, int nworkers, int widx) {
    LAS int* UD = (LAS int*)(F.lds + MISC_OFF + 1024);
    if (F.tid < 8) { pg8::StaticOrder so; so.init(M, N, nworkers, widx < 0 ? (1 << 28) : widx); pg8::Unit u; const bool ok = so.next(F.tid, u); UD[2 * F.tid] = ok ? u.pm : -1; UD[2 * F.tid + 1] = u.pn; }
    __syncthreads();
}
struct ListOrder {
    const LAS int* UD;
    __device__ __forceinline__ bool next(int i, pg8::Unit& u) const { if (i >= 8) return false; const int pm = UD[2 * i]; if (pm < 0) return false; u.pm = pm; u.pn = UD[2 * i + 1]; u.aux = 0; u.rows = 256; u.base = 0; return true; }
};
struct DenseSched {
    static constexpr bool GATHER = false, HALFABLE = false;
    const bf16_t* A; const bf16_t* Bt; int K; ListOrder so;
    __device__ __forceinline__ bool next(int i, pg8::Unit& u) const { return so.next(i, u); }
    __device__ __forceinline__ int kdim(const pg8::Unit&) const { return K; }
    __device__ __forceinline__ const char* a_base(const pg8::Unit& u) const { return (const char*)A + (size_t)u.pm * 256 * K * 2; }
    __device__ __forceinline__ const char* b_base(const pg8::Unit& u) const { return (const char*)Bt + (size_t)u.pn * 256 * K * 2; }
};
struct EpiInProj {
    static constexpr bool STORES16 = true;
    unsigned char* ws; const float* lbl; const float* hng;
    __device__ __forceinline__ bool operator()(f32x4 (&acc)[2][2][4][2], const pg8::Unit& u, int wr, int wc, int fr, int fq) const {
        const int pn = u.pn, row0 = u.pm * 256 + wr * 64 + fr, cl = wc * 32 + 8 * fq;
        if (pn >= 34) {
            bf16_t* GA = (bf16_t*)(ws + WS_GA); bf16_t* GR = (bf16_t*)(ws + WS_GBT); const int c0 = (pn - 34) * 128 + cl;
#pragma unroll
            for (int ai = 0; ai < 2; ++ai)
#pragma unroll
                for (int m = 0; m < 4; ++m) { float sa[8], rr[8];
#pragma unroll
                    for (int j = 0; j < 4; ++j) { const float ea0 = ex2(fminf(-acc[ai][0][m][0][j] * LOG2E, 60.f)), ea1 = ex2(fminf(-acc[ai][0][m][1][j] * LOG2E, 60.f)), eb0 = ex2(fminf(-acc[ai][1][m][0][j] * LOG2E, 60.f)), eb1 = ex2(fminf(-acc[ai][1][m][1][j] * LOG2E, 60.f));
                        sa[j] = __builtin_amdgcn_rcpf(1.f + ea0); sa[4 + j] = __builtin_amdgcn_rcpf(1.f + ea1);
                        rr[j] = (1.f + ea0) * __builtin_amdgcn_rcpf(1.f + eb0); rr[4 + j] = (1.f + ea1) * __builtin_amdgcn_rcpf(1.f + eb1); }
                    u32x4 w, q; w.x = cvt_pk_bf16(sa[0], sa[1]); w.y = cvt_pk_bf16(sa[2], sa[3]); w.z = cvt_pk_bf16(sa[4], sa[5]); w.w = cvt_pk_bf16(sa[6], sa[7]);
                    q.x = cvt_pk_bf16(rr[0], rr[1]); q.y = cvt_pk_bf16(rr[2], rr[3]); q.z = cvt_pk_bf16(rr[4], rr[5]); q.w = cvt_pk_bf16(rr[6], rr[7]);
                    const size_t g = (size_t)(row0 + ai * 128 + m * 16) * D + c0; *(u32x4*)(GA + g) = w; *(u32x4*)(GR + g) = q; }
            return true;
        }
        int kind, ld, colt; size_t off;
        if (pn < 6) { kind = 0; ld = AW; colt = pn * 256; off = WS_QA; }
        else if (pn < 12) { kind = 1; ld = AW; colt = (pn - 6) * 256; off = WS_KA; }
        else if (pn < 18) { kind = 1; ld = AW; colt = (pn - 12) * 256; off = WS_VA; }
        else if (pn < 22) { kind = 2; ld = BW; colt = (pn - 18) * 256; off = WS_QB; }
        else if (pn < 26) { kind = 3; ld = BW; colt = (pn - 22) * 256; off = WS_LOGF; }
        else if (pn < 30) { kind = 1; ld = BW; colt = (pn - 26) * 256; off = WS_IB; }
        else { kind = 4; ld = BW; colt = (pn - 30) * 256; off = WS_GB; }
        bf16_t* O = (bf16_t*)(ws + off);
#pragma unroll
        for (int bj = 0; bj < 2; ++bj) { const int c0 = colt + bj * 128 + cl;
            float gsc[8];
            if (kind == 4) {
#pragma unroll
                for (int j = 0; j < 8; ++j) gsc[j] = hng[c0 + j];
            } else if (kind == 3) {
#pragma unroll
                for (int j = 0; j < 8; ++j) gsc[j] = sigm(lbl[c0 + j] - lbl[BW + c0 + j]);
            }
#pragma unroll
            for (int ai = 0; ai < 2; ++ai)
#pragma unroll
                for (int m = 0; m < 4; ++m) { float v[8];
#pragma unroll
                    for (int j = 0; j < 4; ++j) { v[j] = acc[ai][bj][m][0][j]; v[4 + j] = acc[ai][bj][m][1][j]; }
                    if (kind == 0) {
#pragma unroll
                        for (int j = 0; j < 8; ++j) v[j] *= QSCALE;
                    } else if (kind == 2) {
#pragma unroll
                        for (int j = 0; j < 8; ++j) v[j] *= sigm(v[j]);
                    } else if (kind == 3) {
#pragma unroll
                        for (int j = 0; j < 8; ++j) v[j] = lg2(gsc[j] + (1.f - gsc[j]) * sigm(v[j])) * LN2;
                    } else if (kind == 4) {
#pragma unroll
                        for (int j = 0; j < 8; ++j) v[j] *= sigm(v[j]) * gsc[j];
                    }
                    u32x4 w; w.x = cvt_pk_bf16(v[0], v[1]); w.y = cvt_pk_bf16(v[2], v[3]); w.z = cvt_pk_bf16(v[4], v[5]); w.w = cvt_pk_bf16(v[6], v[7]);
                    *(u32x4*)(O + (size_t)(row0 + ai * 128 + m * 16) * ld + c0) = w; } }
        return true;
    }
};

__device__ __forceinline__ s16x4 tr_read2(unsigned a0, unsigned a1, s16x4& r1) {
    s16x4 r0; asm volatile("ds_read_b64_tr_b16 %0, %2\n\tds_read_b64_tr_b16 %1, %3\n\ts_waitcnt lgkmcnt(0)" : "=&v"(r0), "=&v"(r1) : "v"(a0), "v"(a1) : "memory"); return r0;
}
struct KVRegs { u32x4 k[8], v[8]; };
struct AUnit { int cfg, hd, r, bu; };
template <int NBLK> __device__ __forceinline__ AUnit attn_decode(int cfg, int u) {
    const int dsh = cfg * 2, nbu = (64 >> dsh) / NBLK, lgu = 6 - dsh - (NBLK == 2 ? 1 : 0), rest = u >> lgu;
    return AUnit{cfg, rest >> dsh, rest & ((1 << dsh) - 1), u & (nbu - 1)};
}
template <int BLK> __device__ __forceinline__ void kv_load(Frame& F, const AUnit& a, int b, KVRegs& R) {
    const bf16_t* KA = WSP(bf16_t, WS_KA); const bf16_t* VA = WSP(bf16_t, WS_VA); const int dsh = a.cfg * 2;
#pragma unroll
    for (int it = 0; it < (BLK == 0 ? 8 : 4); ++it) { const int row = (F.tid >> 4) + 32 * it, ch = F.tid & 15; int kidx = (BLK == 0 ? 128 * (b - 1) : 128 * b) + row; kidx = kidx < 0 ? 0 : kidx;
        const size_t g = (size_t)((kidx << dsh) + a.r) * AW + a.hd * 128 + ch * 8;
        R.k[it] = *(const u32x4*)(KA + g); R.v[it] = *(const u32x4*)(VA + g); }
}
template <int BLK> __device__ __forceinline__ void kv_commit(Frame& F, const KVRegs& R) {
    LAS unsigned char* Ks = F.lds; LAS unsigned char* Vs = F.lds + 73728;
#pragma unroll
    for (int it = 0; it < (BLK == 0 ? 8 : 4); ++it) { const int row = (F.tid >> 4) + 32 * it, ch = F.tid & 15;
        *(LAS u32x4*)(Ks + row * 288 + ch * 16) = R.k[it]; *(LAS u32x4*)(Vs + row * 288 + ch * 16) = R.v[it]; }
}
template <bool PH2> __device__ __forceinline__ void attn_phase(Frame& F) {
    constexpr bool MERGE = !PH2; constexpr int NBLK = PH2 ? 2 : 1; constexpr int NU = 768;
    const bf16_t* QA = WSP(bf16_t, WS_QA);
    LAS unsigned char* Ks = F.lds; LAS unsigned char* Vs = F.lds + 73728;
    const int lane = F.lane, w = F.wave, fr = lane & 15, fq = lane >> 4;
    if (F.vcu >= NU) return;
    KVRegs R;
    AUnit a = PH2 ? attn_decode<NBLK>(F.vcu >= 384 ? 1 : 0, F.vcu >= 384 ? F.vcu - 384 : F.vcu) : attn_decode<NBLK>(2, F.vcu);
    kv_load<0>(F, a, a.bu * NBLK, R);
    for (int u = F.vcu; u < NU; u += F.G) {
    const int un = u + F.G;
    const AUnit an = un < NU ? (PH2 ? attn_decode<NBLK>(un >= 384 ? 1 : 0, un >= 384 ? un - 384 : un) : attn_decode<NBLK>(2, un)) : a;
    const int cfg = a.cfg, dsh = cfg * 2, r = a.r, hd = a.hd;
#pragma unroll
    for (int blk = 0; blk < NBLK; ++blk) {
    const int b = a.bu * NBLK + blk, sw = blk << 7;
    if (blk == 0) kv_commit<0>(F, R); else kv_commit<1>(F, R);
    const int qi = 16 * w + fr; const size_t qpos = (size_t)(((128 * b + qi) << dsh) + r);
    bf16x8 qf[4];
#pragma unroll
    for (int kk = 0; kk < 4; ++kk) qf[kk] = *(const bf16x8*)(QA + qpos * AW + hd * 128 + 32 * kk + 8 * fq);
    float l1 = 0.f, l4 = 0.f;
    if constexpr (MERGE) { l1 = WSP(float, WS_LSE1)[qpos * AH + hd]; l4 = WSP(float, WS_LSE4)[qpos * AH + hd]; }
    __syncthreads();
    const int g0 = w >> 1;
    f32x4 S[10];
#pragma unroll
    for (int ti = 0; ti < 10; ++ti) { S[ti] = (f32x4){0.f, 0.f, 0.f, 0.f}; const int kb = (32 * g0 + 16 * ti) ^ sw;
#pragma unroll
        for (int kk = 0; kk < 4; ++kk) { const bf16x8 X = *(const LAS bf16x8*)(Ks + (kb + fr) * 288 + (32 * kk + 8 * fq) * 2);
            S[ti] = __builtin_amdgcn_mfma_f32_16x16x32_bf16(X, qf[kk], S[ti], 0, 0, 0); } }
    float mx = -INFINITY;
#pragma unroll
    for (int ti = 0; ti < 10; ++ti)
#pragma unroll
        for (int e = 0; e < 4; ++e) { const int j = 32 * g0 + 16 * ti + 4 * fq + e; const bool ok = (j >= qi) && (j <= qi + 128) && (b > 0 || j >= 128);
            S[ti][e] = ok ? S[ti][e] : -INFINITY; mx = fmaxf(mx, S[ti][e]); }
    mx = fmaxf(mx, __shfl_xor(mx, 16)); mx = fmaxf(mx, __shfl_xor(mx, 32));
    float l = 0.f; unsigned pk[10][2];
#pragma unroll
    for (int ti = 0; ti < 10; ++ti) { float p[4];
#pragma unroll
        for (int e = 0; e < 4; ++e) { p[e] = ex2(S[ti][e] - mx); l += p[e]; }
        pk[ti][0] = cvt_pk_bf16(p[0], p[1]); pk[ti][1] = cvt_pk_bf16(p[2], p[3]); }
    l += __shfl_xor(l, 16); l += __shfl_xor(l, 32);
    asm volatile("" ::: "memory");
    if (blk + 1 < NBLK) kv_load<1>(F, a, b + 1, R); else if (un < NU) kv_load<0>(F, an, an.bu * NBLK, R);
    asm volatile("" ::: "memory");
    f32x4 acc[8];
#pragma unroll
    for (int dt = 0; dt < 8; ++dt) acc[dt] = (f32x4){0.f, 0.f, 0.f, 0.f};
    const unsigned vbase = (unsigned)(size_t)Vs + (unsigned)((fr & 3) * 8);
    const int vrow = 4 * fq + (fr >> 2);
#pragma unroll
    for (int g = 0; g < 5; ++g) {
        u32x4 yw; yw.x = pk[2 * g][0]; yw.y = pk[2 * g][1]; yw.z = pk[2 * g + 1][0]; yw.w = pk[2 * g + 1][1];
        const bf16x8 Y = __builtin_bit_cast(bf16x8, yw);
        const unsigned ra = vbase + (unsigned)(((32 * (g0 + g) + vrow) ^ sw) * 288), rb2 = vbase + (unsigned)(((32 * (g0 + g) + 16 + vrow) ^ sw) * 288);
#pragma unroll
        for (int dt = 0; dt < 8; ++dt) { s16x4 x1; const s16x4 x0 = tr_read2(ra + dt * 32, rb2 + dt * 32, x1);
            bf16x8 X; X[0] = x0[0]; X[1] = x0[1]; X[2] = x0[2]; X[3] = x0[3]; X[4] = x1[0]; X[5] = x1[1]; X[6] = x1[2]; X[7] = x1[3];
            acc[dt] = __builtin_amdgcn_mfma_f32_16x16x32_bf16(X, Y, acc[dt], 0, 0, 0); }
    }
    const float inv = 1.0f / l, lse = mx + lg2(l);
    if constexpr (!MERGE) {
        bf16_t* O = cfg == 0 ? WSP(bf16_t, WS_O1) : WSP(bf16_t, WS_O4); float* L = cfg == 0 ? WSP(float, WS_LSE1) : WSP(float, WS_LSE4);
#pragma unroll
        for (int dt = 0; dt < 8; ++dt) { u32x2 o; o.x = cvt_pk_bf16(acc[dt][0] * inv, acc[dt][1] * inv); o.y = cvt_pk_bf16(acc[dt][2] * inv, acc[dt][3] * inv);
            *(u32x2*)(O + qpos * AW + hd * 128 + 16 * dt + 4 * fq) = o; }
        if (fq == 0) L[qpos * AH + hd] = lse;
    } else {
        const float M = fmaxf(fmaxf(l1, l4), lse); const float w1 = ex2(l1 - M), w4 = ex2(l4 - M), w16 = ex2(lse - M); const float iw = 1.0f / (w1 + w4 + w16);
        const float c1 = w1 * iw, c4 = w4 * iw, c16 = w16 * iw * inv;
        const bf16_t* O1 = WSP(bf16_t, WS_O1); const bf16_t* O4 = WSP(bf16_t, WS_O4); bf16_t* OA = WSP(bf16_t, WS_OA);
#pragma unroll
        for (int dt = 0; dt < 8; ++dt) { const size_t g = qpos * AW + hd * 128 + 16 * dt + 4 * fq; const u32x2 a1 = *(const u32x2*)(O1 + g), c = *(const u32x2*)(O4 + g);
            u32x2 o; o.x = cvt_pk_bf16(c1 * bf_lo(a1.x) + c4 * bf_lo(c.x) + c16 * acc[dt][0], c1 * bf_hi(a1.x) + c4 * bf_hi(c.x) + c16 * acc[dt][1]);
            o.y = cvt_pk_bf16(c1 * bf_lo(a1.y) + c4 * bf_lo(c.y) + c16 * acc[dt][2], c1 * bf_hi(a1.y) + c4 * bf_hi(c.y) + c16 * acc[dt][3]);
            *(u32x2*)(OA + g) = o; }
    }
    __syncthreads();
    }
    a = an;
    }
}

constexpr int HG_LF = 0, HG_BC = 33792, HG_VS = 67584, HG_SS = 86016, HG_RED = 120832;
struct HgTile { u32x4 lf[2], vv[2], sv[4]; };
template <bool WITH_STATE> __device__ __forceinline__ void hg_load(Frame& F, int u, HgTile& t) {
    const int hd = u >> 7, c = u & 127;
    const bf16_t* LOGF = WSP(bf16_t, WS_LOGF); const bf16_t* IB = WSP(bf16_t, WS_IB);
#pragma unroll
    for (int it = 0; it < 2; ++it) { const int idx = F.tid + 512 * it, row = idx >> 4, ch = idx & 15; const size_t g = (size_t)(64 * c + row) * BW + hd * 128 + 8 * ch;
        t.lf[it] = *(const u32x4*)(LOGF + g); t.vv[it] = *(const u32x4*)(IB + g); }
    if constexpr (WITH_STATE) { const bf16_t* ST = WSP(bf16_t, WS_ST) + ((size_t)(hd * 128 + c) * 128) * 128;
#pragma unroll
        for (int it = 0; it < 4; ++it) t.sv[it] = *(const u32x4*)(ST + (size_t)(F.tid + 512 * it) * 8); }
}
template <bool WITH_STATE> __device__ __forceinline__ void hg_commit(Frame& F, const HgTile& t) {
    LAS float* LF = (LAS float*)(F.lds + HG_LF); LAS float* BC = (LAS float*)(F.lds + HG_BC); LAS unsigned char* Vs = F.lds + HG_VS; LAS unsigned char* SS = F.lds + HG_SS;
#pragma unroll
    for (int it = 0; it < 2; ++it) { const int idx = F.tid + 512 * it, row = idx >> 4, ch = idx & 15;
        *(LAS f32x4*)(LF + row * 132 + 8 * ch) = (f32x4){bf_lo(t.lf[it].x), bf_hi(t.lf[it].x), bf_lo(t.lf[it].y), bf_hi(t.lf[it].y)};
        *(LAS f32x4*)(LF + row * 132 + 8 * ch + 4) = (f32x4){bf_lo(t.lf[it].z), bf_hi(t.lf[it].z), bf_lo(t.lf[it].w), bf_hi(t.lf[it].w)};
        *(LAS u32x4*)(Vs + row * 288 + ch * 16) = t.vv[it]; }
    if constexpr (WITH_STATE) {
#pragma unroll
        for (int it = 0; it < 4; ++it) { const int idx = F.tid + 512 * it, v = idx >> 4, k8 = idx & 15; *(LAS u32x4*)(SS + v * 272 + k8 * 16) = t.sv[it]; } }
    __syncthreads();
    if (F.tid < 128) { float run = 0.f;
#pragma unroll 8
        for (int s = 0; s < 64; ++s) { run += LF[s * 132 + F.tid]; BC[s * 132 + F.tid] = run; } }
    __syncthreads();
}
__device__ __forceinline__ void hgrn_local_unit(Frame& F, int u, HgTile& t, int unext) {
    const int hd = u >> 7, c = u & 127;
    hg_commit<false>(F, t);
    if (unext < BH * NCH) hg_load<false>(F, unext, t);
    LAS float* LF = (LAS float*)(F.lds + HG_LF); LAS float* BC = (LAS float*)(F.lds + HG_BC); LAS unsigned char* Vs = F.lds + HG_VS;
    const int lane = F.lane, w = F.wave, fr = lane & 15, fq = lane >> 4, kch = 16 * w + fr;
    const float blast = BC[63 * 132 + kch];
    bf16x8 X[2];
#pragma unroll
    for (int ks = 0; ks < 2; ++ks) { float v[8];
#pragma unroll
        for (int j = 0; j < 8; ++j) { const int s = 32 * ks + 8 * fq + j; v[j] = (1.0f - expn(LF[s * 132 + kch])) * expn(blast - BC[s * 132 + kch]); }
        u32x4 xw; xw.x = cvt_pk_bf16(v[0], v[1]); xw.y = cvt_pk_bf16(v[2], v[3]); xw.z = cvt_pk_bf16(v[4], v[5]); xw.w = cvt_pk_bf16(v[6], v[7]); X[ks] = __builtin_bit_cast(bf16x8, xw); }
    const unsigned vbase = (unsigned)(size_t)Vs + (unsigned)((8 * fq + (fr >> 2)) * 288 + (fr & 3) * 8);
    bf16_t* ST = WSP(bf16_t, WS_ST) + ((size_t)(hd * 128 + c) * 128) * 128;
#pragma unroll
    for (int vt = 0; vt < 8; ++vt) { f32x4 a = (f32x4){0.f, 0.f, 0.f, 0.f};
#pragma unroll
        for (int ks = 0; ks < 2; ++ks) { const unsigned rb = vbase + (unsigned)(32 * ks) * 288u + vt * 32; s16x4 y1; const s16x4 y0 = tr_read2(rb, rb + 4 * 288, y1);
            bf16x8 Y; Y[0] = y0[0]; Y[1] = y0[1]; Y[2] = y0[2]; Y[3] = y0[3]; Y[4] = y1[0]; Y[5] = y1[1]; Y[6] = y1[2]; Y[7] = y1[3];
            a = __builtin_amdgcn_mfma_f32_16x16x32_bf16(X[ks], Y, a, 0, 0, 0); }
        u32x2 o; o.x = cvt_pk_bf16(a[0], a[1]); o.y = cvt_pk_bf16(a[2], a[3]); *(u32x2*)(ST + (size_t)(16 * vt + fr) * 128 + 16 * w + 4 * fq) = o; }
    if (F.tid < 128) WSP(float, WS_DEC)[(hd * 128 + c) * 128 + F.tid] = expn(BC[63 * 132 + F.tid]);
    __syncthreads();
}
template <bool DRY> __device__ __forceinline__ void hgrn_scan(Frame& F) {
    unsigned* ST = WSP(unsigned, WS_ST); const float* DEC = WSP(float, WS_DEC); unsigned* DUM = WSP(unsigned, WS_XN);
    LAS float* DL = (LAS float*)F.lds;
    for (int base = F.vcu * 256; base < BH * 8192; base += F.G * 256) {
        const int hd = base >> 13;
        { const f32x4* src = (const f32x4*)(DEC + hd * 128 * 128);
#pragma unroll
          for (int it = 0; it < 8; ++it) { const int i = F.tid + 512 * it; *(LAS f32x4*)(DL + 4 * i) = src[i]; } }
        __syncthreads();
        if (F.tid < 256) {
            const int idx = base + F.tid, vk2 = idx & 8191, k2 = vk2 & 63;
            unsigned* p = ST + (size_t)hd * 128 * 8192 + vk2; const LAS f32x2* d = (const LAS f32x2*)DL + k2;
            float S0 = 0.f, S1 = 0.f;
            for (int c0 = 0; c0 < NCH; c0 += 32) { unsigned tv[32];
#pragma unroll
                for (int j = 0; j < 32; ++j) tv[j] = p[(size_t)(c0 + j) * 8192];
#pragma unroll
                for (int j = 0; j < 32; ++j) { const unsigned o = cvt_pk_bf16(S0, S1); const f32x2 dv = d[(c0 + j) * 64];
                    if (DRY) DUM[(((size_t)hd * 128 + (c0 + j)) * 8192 + vk2) & (8u * 1024 * 1024 - 1)] = o; else p[(size_t)(c0 + j) * 8192] = o;
                    S0 = dv.x * S0 + bf_lo(tv[j]); S1 = dv.y * S1 + bf_hi(tv[j]); } }
        }
        __syncthreads();
    }
}
__device__ __forceinline__ void hgrn_out_unit(Frame& F, int u, HgTile& t, int unext) {
    const int hd = u >> 7, c = u & 127;
    LAS float* LF = (LAS float*)(F.lds + HG_LF); LAS float* BC = (LAS float*)(F.lds + HG_BC); LAS unsigned char* Vs = F.lds + HG_VS; LAS unsigned char* SS = F.lds + HG_SS; LAS float* RED = (LAS float*)(F.lds + HG_RED);
    hg_commit<true>(F, t);
    const int lane = F.lane, w = F.wave, fr = lane & 15, fq = lane >> 4, i = w >> 1, vh = w & 1;
    const bf16_t* QB = WSP(bf16_t, WS_QB);
    const size_t trow = (size_t)(64 * c + 16 * i + fr);
    bf16x8 qi_f[4], q0_f[4]; float bi[32];
    u32x4 qraw[4]; u32x2 gbv[4]; const bf16_t* GB = WSP(bf16_t, WS_GB);
#pragma unroll
    for (int kk = 0; kk < 4; ++kk) qraw[kk] = *(const u32x4*)(QB + trow * BW + hd * 128 + 32 * kk + 8 * fq);
#pragma unroll
    for (int vt = 0; vt < 4; ++vt) gbv[vt] = *(const u32x2*)(GB + trow * BW + hd * 128 + 16 * (4 * vh + vt) + 4 * fq);
    asm volatile("" ::: "memory");
    if (unext < BH * NCH) hg_load<true>(F, unext, t);
    asm volatile("" ::: "memory");
#pragma unroll
    for (int kk = 0; kk < 4; ++kk) { const u32x4 qw = qraw[kk];
        const float q[8] = {bf_lo(qw.x), bf_hi(qw.x), bf_lo(qw.y), bf_hi(qw.y), bf_lo(qw.z), bf_hi(qw.z), bf_lo(qw.w), bf_hi(qw.w)};
        float a[8], z[8];
#pragma unroll
        for (int j = 0; j < 8; ++j) { const int k = 32 * kk + 8 * fq + j; const float bct = BC[(16 * i + fr) * 132 + k]; const float b = i ? BC[(16 * i - 1) * 132 + k] : 0.f; bi[kk * 8 + j] = b;
            a[j] = q[j] * expn(bct - b); z[j] = q[j] * expn(bct); }
        u32x4 aw, zw; aw.x = cvt_pk_bf16(a[0], a[1]); aw.y = cvt_pk_bf16(a[2], a[3]); aw.z = cvt_pk_bf16(a[4], a[5]); aw.w = cvt_pk_bf16(a[6], a[7]);
        zw.x = cvt_pk_bf16(z[0], z[1]); zw.y = cvt_pk_bf16(z[2], z[3]); zw.z = cvt_pk_bf16(z[4], z[5]); zw.w = cvt_pk_bf16(z[6], z[7]);
        qi_f[kk] = __builtin_bit_cast(bf16x8, aw); q0_f[kk] = __builtin_bit_cast(bf16x8, zw); }
    unsigned pk[4][2];
#pragma unroll
    for (int j = 0; j < 4; ++j) {
        pk[j][0] = 0u; pk[j][1] = 0u;
        if (j <= i) {
            f32x4 a = (f32x4){0.f, 0.f, 0.f, 0.f}; const int s = 16 * j + fr;
#pragma unroll
            for (int kk = 0; kk < 4; ++kk) { float v[8];
#pragma unroll
                for (int jj = 0; jj < 8; ++jj) { const int k = 32 * kk + 8 * fq + jj; v[jj] = (1.0f - expn(LF[s * 132 + k])) * expn(fminf(bi[kk * 8 + jj] - BC[s * 132 + k], 80.f)); }
                u32x4 xw; xw.x = cvt_pk_bf16(v[0], v[1]); xw.y = cvt_pk_bf16(v[2], v[3]); xw.z = cvt_pk_bf16(v[4], v[5]); xw.w = cvt_pk_bf16(v[6], v[7]);
                a = __builtin_amdgcn_mfma_f32_16x16x32_bf16(__builtin_bit_cast(bf16x8, xw), qi_f[kk], a, 0, 0, 0); }
            if (j == i) {
#pragma unroll
                for (int e = 0; e < 4; ++e) a[e] = (4 * fq + e <= fr) ? a[e] : 0.f;
            }
            pk[j][0] = cvt_pk_bf16(a[0], a[1]); pk[j][1] = cvt_pk_bf16(a[2], a[3]);
        }
    }
    f32x4 acc[4];
#pragma unroll
    for (int vt = 0; vt < 4; ++vt) acc[vt] = (f32x4){0.f, 0.f, 0.f, 0.f};
    const unsigned vbase = (unsigned)(size_t)Vs + (unsigned)((4 * fq + (fr >> 2)) * 288 + (fr & 3) * 8);
#pragma unroll
    for (int g2 = 0; g2 < 2; ++g2) {
        if (2 * g2 <= i) {
            u32x4 yw; yw.x = pk[2 * g2][0]; yw.y = pk[2 * g2][1]; yw.z = pk[2 * g2 + 1][0]; yw.w = pk[2 * g2 + 1][1]; const bf16x8 Y = __builtin_bit_cast(bf16x8, yw);
#pragma unroll
            for (int vt = 0; vt < 4; ++vt) { const unsigned rb = vbase + (unsigned)(32 * g2) * 288u + (unsigned)(4 * vh + vt) * 32u; s16x4 x1; const s16x4 x0 = tr_read2(rb, rb + 16 * 288, x1);
                bf16x8 X; X[0] = x0[0]; X[1] = x0[1]; X[2] = x0[2]; X[3] = x0[3]; X[4] = x1[0]; X[5] = x1[1]; X[6] = x1[2]; X[7] = x1[3];
                acc[vt] = __builtin_amdgcn_mfma_f32_16x16x32_bf16(X, Y, acc[vt], 0, 0, 0); }
        }
    }
#pragma unroll
    for (int kk = 0; kk < 4; ++kk)
#pragma unroll
        for (int vt = 0; vt < 4; ++vt) { const bf16x8 X = *(const LAS bf16x8*)(SS + (16 * (4 * vh + vt) + fr) * 272 + (32 * kk + 8 * fq) * 2);
            acc[vt] = __builtin_amdgcn_mfma_f32_16x16x32_bf16(X, q0_f[kk], acc[vt], 0, 0, 0); }
    float ss = 0.f;
#pragma unroll
    for (int vt = 0; vt < 4; ++vt) ss += (acc[vt][0] * acc[vt][0] + acc[vt][1] * acc[vt][1]) + (acc[vt][2] * acc[vt][2] + acc[vt][3] * acc[vt][3]);
    ss += __shfl_xor(ss, 16); ss += __shfl_xor(ss, 32);
    if (fq == 0) RED[vh * 64 + 16 * i + fr] = ss;
    __syncthreads();
    const float rstd = __builtin_amdgcn_rsqf((RED[16 * i + fr] + RED[64 + 16 * i + fr]) * (1.f / 128.f) + EPS);
    bf16_t* OB = WSP(bf16_t, WS_OB);
#pragma unroll
    for (int vt = 0; vt < 4; ++vt) { const size_t g = trow * BW + hd * 128 + 16 * (4 * vh + vt) + 4 * fq; const u32x2 gb = gbv[vt];
        u32x2 o; o.x = cvt_pk_bf16(acc[vt][0] * rstd * bf_lo(gb.x), acc[vt][1] * rstd * bf_hi(gb.x)); o.y = cvt_pk_bf16(acc[vt][2] * rstd * bf_lo(gb.y), acc[vt][3] * rstd * bf_hi(gb.y));
        *(u32x2*)(OB + g) = o; }
    __syncthreads();
}

struct MergedSched {
    static constexpr bool GATHER = false, HALFABLE = false;
    const bf16_t *OA, *WA, *OB, *WB; ListOrder so;
    __device__ __forceinline__ bool next(int i, pg8::Unit& u) const { if (!so.next(i >> 1, u)) return false; u.aux = i & 1; return true; }
    __device__ __forceinline__ int kdim(const pg8::Unit& u) const { return u.aux ? AW : BW; }
    __device__ __forceinline__ const char* a_base(const pg8::Unit& u) const { return u.aux ? (const char*)OA + (size_t)u.pm * 256 * AW * 2 : (const char*)OB + (size_t)u.pm * 256 * BW * 2; }
    __device__ __forceinline__ const char* b_base(const pg8::Unit& u) const { return u.aux ? (const char*)WA + (size_t)u.pn * 256 * AW * 2 : (const char*)WB + (size_t)u.pn * 256 * BW * 2; }
};
struct EpiMerged {
    static constexpr bool STORES16 = false;
    const bf16_t *GA, *GR; bf16_t* O;
    __device__ __forceinline__ bool operator()(f32x4 (&acc)[2][2][4][2], const pg8::Unit& u, int wr, int wc, int fr, int fq) const {
        const int row0 = u.pm * 256 + wr * 64 + fr, col0 = u.pn * 256 + wc * 32 + 8 * fq; const bf16_t* Gs = u.aux ? GA : GR;
#pragma unroll
        for (int ai = 0; ai < 2; ++ai)
#pragma unroll
            for (int m = 0; m < 4; ++m)
#pragma unroll
                for (int bj = 0; bj < 2; ++bj) { const size_t g = (size_t)(row0 + ai * 128 + m * 16) * D + col0 + bj * 128;
                    const u32x4 a = *(const u32x4*)(Gs + g);
                    const float sa[8] = {bf_lo(a.x), bf_hi(a.x), bf_lo(a.y), bf_hi(a.y), bf_lo(a.z), bf_hi(a.z), bf_lo(a.w), bf_hi(a.w)};
                    if (u.aux == 0) {
#pragma unroll
                        for (int j = 0; j < 4; ++j) { acc[ai][bj][m][0][j] *= sa[j]; acc[ai][bj][m][1][j] *= sa[4 + j]; }
                    } else { u32x4 w; w.x = cvt_pk_bf16(acc[ai][bj][m][0][0] * sa[0], acc[ai][bj][m][0][1] * sa[1]); w.y = cvt_pk_bf16(acc[ai][bj][m][0][2] * sa[2], acc[ai][bj][m][0][3] * sa[3]);
                        w.z = cvt_pk_bf16(acc[ai][bj][m][1][0] * sa[4], acc[ai][bj][m][1][1] * sa[5]); w.w = cvt_pk_bf16(acc[ai][bj][m][1][2] * sa[6], acc[ai][bj][m][1][3] * sa[7]);
                        *(u32x4*)(O + g) = w; } }
        return u.aux != 0;
    }
};
struct EpiResid {   static constexpr bool STORES16 = false;
    bf16_t* O;
    __device__ __forceinline__ bool operator()(f32x4 (&acc)[2][2][4][2], const pg8::Unit& u, int wr, int wc, int fr, int fq) const {
        const int row0 = u.pm * 256 + wr * 64 + fr, col0 = u.pn * 256 + wc * 32 + 8 * fq;
#pragma unroll
        for (int ai = 0; ai < 2; ++ai)
#pragma unroll
            for (int m = 0; m < 4; ++m)
#pragma unroll
                for (int bj = 0; bj < 2; ++bj) { const size_t g = (size_t)(row0 + ai * 128 + m * 16) * D + col0 + bj * 128;
                    u32x4 w; w.x = cvt_pk_bf16(acc[ai][bj][m][0][0], acc[ai][bj][m][0][1]); w.y = cvt_pk_bf16(acc[ai][bj][m][0][2], acc[ai][bj][m][0][3]);
                    w.z = cvt_pk_bf16(acc[ai][bj][m][1][0], acc[ai][bj][m][1][1]); w.w = cvt_pk_bf16(acc[ai][bj][m][1][2], acc[ai][bj][m][1][3]);
                    *(u32x4*)(O + g) = w; }
        return true;
    }
};

struct RTile { f32x4 ha[2], hb[2], w0[2], w1[2], w2[2]; u32x4 ma, mb; };
__device__ __forceinline__ void rt_load(RTile& r, const float* Ha, const float* Hb, const bf16_t* Ma, const bf16_t* Mb, const float* WTR, int tk, int kb) {
    r.ma = *(const u32x4*)(Ma + kb); r.mb = *(const u32x4*)(Mb + kb);
#pragma unroll
    for (int s = 0; s < 2; ++s) { r.ha[s] = *(const f32x4*)(Ha + kb + 4 * s); r.hb[s] = *(const f32x4*)(Hb + kb + 4 * s);
        r.w0[s] = tk < 4 ? *(const f32x4*)(WTR + (size_t)tk * D + kb + 4 * s) : (f32x4){0.f, 0.f, 0.f, 0.f};
        r.w1[s] = *(const f32x4*)(WTR + (size_t)(16 + tk) * D + kb + 4 * s); r.w2[s] = *(const f32x4*)(WTR + (size_t)(32 + tk) * D + kb + 4 * s); }
}
template <bool DRY> __device__ __forceinline__ void p7_router(Frame& F) {
    const int lane = F.lane, w = F.wave, tk = lane & 15, kq = lane >> 4;
    const float* WTR = WSP(float, WS_WTR);
    LAS float* PART = (LAS float*)F.lds;
    for (int pair = F.vcu; pair < T / 32; pair += F.G) {
        const int t0 = 32 * pair;
        const float* Ha = F.in[0] + (size_t)(t0 + tk) * D; const float* Hb = Ha + (size_t)16 * D;
        const bf16_t* Ma = WSP(bf16_t, WS_HM) + (size_t)(t0 + tk) * D; const bf16_t* Mb = Ma + (size_t)16 * D;
        bf16_t* Na = (DRY ? WSP(bf16_t, WS_W2) : WSP(bf16_t, WS_XN)) + (size_t)(t0 + tk) * D; bf16_t* Nb = Na + (size_t)16 * D;
        f32x4 a0 = (f32x4){0.f, 0.f, 0.f, 0.f}, a1 = a0, a2 = a0, b0 = a0, b1 = a0, b2 = a0; float ssa = 0.f, ssb = 0.f;
        RTile cur, nxt; rt_load(cur, Ha, Hb, Ma, Mb, WTR, tk, 256 * w + 8 * kq);
#pragma unroll 1
        for (int j = 0; j < 8; ++j) {
            const int kb = 256 * w + 32 * j + 8 * kq, jn = (j + 1) & 7;
            rt_load(nxt, Ha, Hb, Ma, Mb, WTR, tk, 256 * w + 32 * jn + 8 * kq);
            asm volatile("" ::: "memory");
            cur.ha[0] = cur.ha[0] + (f32x4){bf_lo(cur.ma.x), bf_hi(cur.ma.x), bf_lo(cur.ma.y), bf_hi(cur.ma.y)}; cur.ha[1] = cur.ha[1] + (f32x4){bf_lo(cur.ma.z), bf_hi(cur.ma.z), bf_lo(cur.ma.w), bf_hi(cur.ma.w)};
            cur.hb[0] = cur.hb[0] + (f32x4){bf_lo(cur.mb.x), bf_hi(cur.mb.x), bf_lo(cur.mb.y), bf_hi(cur.mb.y)}; cur.hb[1] = cur.hb[1] + (f32x4){bf_lo(cur.mb.z), bf_hi(cur.mb.z), bf_lo(cur.mb.w), bf_hi(cur.mb.w)};
#pragma unroll
            for (int s = 0; s < 2; ++s) { ssa += (cur.ha[s].x * cur.ha[s].x + cur.ha[s].y * cur.ha[s].y) + (cur.ha[s].z * cur.ha[s].z + cur.ha[s].w * cur.ha[s].w);
                ssb += (cur.hb[s].x * cur.hb[s].x + cur.hb[s].y * cur.hb[s].y) + (cur.hb[s].z * cur.hb[s].z + cur.hb[s].w * cur.hb[s].w); }
            u32x4 oa, ob;
            oa.x = cvt_pk_bf16(cur.ha[0].x, cur.ha[0].y); oa.y = cvt_pk_bf16(cur.ha[0].z, cur.ha[0].w); oa.z = cvt_pk_bf16(cur.ha[1].x, cur.ha[1].y); oa.w = cvt_pk_bf16(cur.ha[1].z, cur.ha[1].w);
            ob.x = cvt_pk_bf16(cur.hb[0].x, cur.hb[0].y); ob.y = cvt_pk_bf16(cur.hb[0].z, cur.hb[0].w); ob.z = cvt_pk_bf16(cur.hb[1].x, cur.hb[1].y); ob.w = cvt_pk_bf16(cur.hb[1].z, cur.hb[1].w);
            *(u32x4*)(Na + kb) = oa; *(u32x4*)(Nb + kb) = ob;
#pragma unroll
            for (int s = 0; s < 2; ++s)
#pragma unroll
                for (int e = 0; e < 4; ++e) { a0 = __builtin_amdgcn_mfma_f32_16x16x4f32(cur.ha[s][e], cur.w0[s][e], a0, 0, 0, 0); a1 = __builtin_amdgcn_mfma_f32_16x16x4f32(cur.ha[s][e], cur.w1[s][e], a1, 0, 0, 0); a2 = __builtin_amdgcn_mfma_f32_16x16x4f32(cur.ha[s][e], cur.w2[s][e], a2, 0, 0, 0);
                    b0 = __builtin_amdgcn_mfma_f32_16x16x4f32(cur.hb[s][e], cur.w0[s][e], b0, 0, 0, 0); b1 = __builtin_amdgcn_mfma_f32_16x16x4f32(cur.hb[s][e], cur.w1[s][e], b1, 0, 0, 0); b2 = __builtin_amdgcn_mfma_f32_16x16x4f32(cur.hb[s][e], cur.w2[s][e], b2, 0, 0, 0); }
            cur = nxt;
        }
        ssa += __shfl_xor(ssa, 16); ssa += __shfl_xor(ssa, 32); ssb += __shfl_xor(ssb, 16); ssb += __shfl_xor(ssb, 32);
        { LAS float* P = PART + w * 1664;
#pragma unroll
          for (int e = 0; e < 4; ++e) { P[(4 * kq + e) * 52 + tk] = a0[e]; P[(4 * kq + e) * 52 + 16 + tk] = a1[e]; P[(4 * kq + e) * 52 + 32 + tk] = a2[e];
              P[832 + (4 * kq + e) * 52 + tk] = b0[e]; P[832 + (4 * kq + e) * 52 + 16 + tk] = b1[e]; P[832 + (4 * kq + e) * 52 + 32 + tk] = b2[e]; }
          if (kq == 0) { P[tk * 52 + 48] = ssa; P[832 + tk * 52 + 48] = ssb; } }
        __syncthreads();
        LAS unsigned* LC = (LAS unsigned*)(F.lds + 57344); LAS unsigned* LB = LC + 32;
        if (F.tid < 32) LC[F.tid] = 0u;
        __syncthreads();
        const bool router = (w < 2 && lane < 16);
        int e0 = 0, e1 = 0; unsigned rk0 = 0, rk1 = 0; float wt0 = 0.f, wt1 = 0.f, rstd = 0.f; const int t = t0 + 16 * (w & 1) + (lane & 15);
        if (router) {
            const LAS float* q = PART + (w & 1) * 832 + lane * 52; const float* rbg = F.in[10]; const float* rbe = F.in[12];
#define RSUM(o) (((q[(o)] + q[1664 + (o)]) + (q[3328 + (o)] + q[4992 + (o)])) + ((q[6656 + (o)] + q[8320 + (o)]) + (q[9984 + (o)] + q[11648 + (o)])))
            rstd = __builtin_amdgcn_rsqf(RSUM(48) * (1.f / D) + EPS);
            float gl[4]; int gi = 0; float gm;
#pragma unroll
            for (int o = 0; o < 4; ++o) gl[o] = RSUM(o) * rstd + rbg[o];
            gm = gl[0];
#pragma unroll
            for (int o = 1; o < 4; ++o) if (gl[o] > gm) { gm = gl[o]; gi = o; }
            float den = 0.f;
#pragma unroll
            for (int o = 0; o < 4; ++o) den += expn(gl[o] - gm);
            const float pg = 1.0f / den;
            float v0 = -INFINITY, v1 = -INFINITY; int i0 = 0, i1 = 0;
#pragma unroll
            for (int x = 0; x < 8; ++x) { const float v = RSUM(16 + 8 * gi + x) * rstd + rbe[8 * gi + x];
                if (v > v0) { v1 = v0; i1 = i0; v0 = v; i0 = x; } else if (v > v1) { v1 = v; i1 = x; } }
#undef RSUM
            const float p0 = 1.0f / (1.0f + expn(v1 - v0)), p1 = 1.0f - p0;
            e0 = 8 * gi + i0; e1 = 8 * gi + i1; wt0 = p0 * pg; wt1 = p1 * pg;
            rk0 = __hip_atomic_fetch_add(LC + e0, 1u, __ATOMIC_RELAXED, __HIP_MEMORY_SCOPE_WORKGROUP); rk1 = __hip_atomic_fetch_add(LC + e1, 1u, __ATOMIC_RELAXED, __HIP_MEMORY_SCOPE_WORKGROUP);
        }
        __syncthreads();
        if (F.tid < 32) { const unsigned n = LC[F.tid]; unsigned* CN = F.ctl + CW_CNT + (DRY ? 64 * NE : 0); LB[F.tid] = n ? atomicAdd(CN + 64 * F.tid, n) : 0u; }
        __syncthreads();
        if (router) {
            int* TL = DRY ? WSP(int, WS_W2 + 40 * MiB) : WSP(int, WS_TOKL); float* TW = DRY ? WSP(float, WS_W2 + 42 * MiB) : WSP(float, WS_TOKW);
            int* SP = DRY ? WSP(int, WS_W2 + 46 * MiB) : WSP(int, WS_SP); float* SW = DRY ? WSP(float, WS_W2 + 47 * MiB) : WSP(float, WS_SW);
            const unsigned pos0 = (LB[e0] + rk0) & (CAP - 1), pos1 = (LB[e1] + rk1) & (CAP - 1);
            TL[e0 * CAP + pos0] = 2 * t; TW[e0 * CAP + pos0] = wt0; SP[2 * t] = (e0 << 16) | (int)pos0; SW[2 * t] = wt0;
            TL[e1 * CAP + pos1] = 2 * t + 1; TW[e1 * CAP + pos1] = wt1; SP[2 * t + 1] = (e1 << 16) | (int)pos1; SW[2 * t + 1] = wt1;
            (DRY ? WSP(float, WS_W2 + 44 * MiB) : WSP(float, WS_RSTD))[t] = rstd;
        }
        __syncthreads();
    }
}
__device__ __forceinline__ void p8_filler(Frame& F, int li, int NL) {
    LAS float* scr = (LAS float*)(F.lds + F.wave * TSCR);
    const int gw = li * 8 + F.wave, NGW = NL * 8;
    for (int it = W2E0 * 256 + gw; it < NE * 256; it += 4 * NGW) {
        const int i1 = it + NGW, i2 = it + 2 * NGW, i3 = it + 3 * NGW;
        TrItem a = p8_item(F, it), b = p8_item(F, i1 < NE * 256 ? i1 : it);
        f32x4 va[16], vb[16];
        tr64_load<false>(va, a.W, a.ldw, a.k0, a.n0, F.lane); if (i1 < NE * 256) tr64_load<false>(vb, b.W, b.ldw, b.k0, b.n0, F.lane);
        tr64_finish<false>(va, a.k0, a.WT, a.ldt, a.drow0, scr, F.lane);
        if (i2 < NE * 256) { a = p8_item(F, i2); tr64_load<false>(va, a.W, a.ldw, a.k0, a.n0, F.lane); }
        if (i1 < NE * 256) tr64_finish<false>(vb, b.k0, b.WT, b.ldt, b.drow0, scr, F.lane);
        if (i3 < NE * 256) { b = p8_item(F, i3); tr64_load<false>(vb, b.W, b.ldw, b.k0, b.n0, F.lane); }
        if (i2 < NE * 256) tr64_finish<false>(va, a.k0, a.WT, a.ldt, a.drow0, scr, F.lane);
        if (i3 < NE * 256) tr64_finish<false>(vb, b.k0, b.WT, b.ldt, b.drow0, scr, F.lane);
    }
}

template <int NPN> __device__ __forceinline__ void moe_tables(Frame& F) {
    LAS int* TP = (LAS int*)(F.lds + MISC_OFF + 256); LAS int* RO = TP + 40; LAS int* CN = RO + 40; LAS int* UL = CN + 40; LAS int* TI = (LAS int*)(F.lds + MISC_OFF + 2048);
    if (F.tid < NE) { int n = (int)__hip_atomic_load(F.ctl + CW_CNT + 64 * F.tid, __ATOMIC_RELAXED, __HIP_MEMORY_SCOPE_AGENT); CN[F.tid] = n > CAP ? CAP : n; }
    __syncthreads();
    if (F.tid == 0) { int tp = 0, ro = 0;
        for (int e = 0; e < NE; ++e) { const int n = CN[e]; TP[e] = tp; RO[e] = ro; tp += (n + 255) >> 8; ro += n; }
        TP[NE] = tp; RO[NE] = ro;
        int k = 0;
        for (int e = 0; e < NE; ++e) { const int n = CN[e], nt = (n + 255) >> 8; for (int mt = 0; mt < nt; ++mt) if (n - 256 * mt > 128) TI[k++] = (e << 8) | mt; }
        for (int e = 0; e < NE; ++e) { const int n = CN[e], nt = (n + 255) >> 8; for (int mt = 0; mt < nt; ++mt) if (n - 256 * mt <= 128) TI[k++] = (e << 8) | mt; } }
    __syncthreads();
    if (F.tid < 8) { const int L = F.tid * F.G + F.vcu, total = TP[NE] * NPN; int e = 0, mt = 0, pn = 0;
        if (L < total) { const int ti = TI[L / NPN]; pn = L % NPN; e = ti >> 8; mt = ti & 255; }
        const int n = CN[e] - 256 * mt;
        UL[F.tid * 5 + 0] = (L < total) ? e : -1; UL[F.tid * 5 + 1] = mt; UL[F.tid * 5 + 2] = pn; UL[F.tid * 5 + 3] = n < 256 ? n : 256; UL[F.tid * 5 + 4] = RO[e] + 256 * mt; }
    __syncthreads();
}
struct MoeOrder {
    const LAS int* UL;
    __device__ __forceinline__ bool next(int i, pg8::Unit& u) const {
        if (i >= 8) return false; const int e = UL[i * 5]; if (e < 0) return false;
        u.aux = e; u.pm = UL[i * 5 + 1]; u.pn = UL[i * 5 + 2]; u.rows = UL[i * 5 + 3]; u.base = UL[i * 5 + 4]; return true;
    }
};
struct Moe1Sched {
    static constexpr bool GATHER = true, HALFABLE = true;
    MoeOrder mo; const bf16_t* HN; const bf16_t* W13; const int* TL;
    __device__ __forceinline__ bool next(int i, pg8::Unit& u) const { return mo.next(i, u); }
    __device__ __forceinline__ int kdim(const pg8::Unit&) const { return D; }
    __device__ __forceinline__ const char* a_base(const pg8::Unit&) const { return (const char*)HN; }
    __device__ __forceinline__ const char* b_base(const pg8::Unit& u) const { return (const char*)W13 + ((size_t)u.aux * 1024 + (size_t)u.pn * 256) * D * 2; }
    __device__ __forceinline__ unsigned a_row_off(const pg8::Unit& u, int r) const { const int idx = 256 * u.pm + r; const int ts = TL[u.aux * CAP + (r < u.rows ? idx : 0)]; return (unsigned)(ts >> 1) * (unsigned)(D * 2); }
};
struct EpiMoe1 {         static constexpr bool STORES16 = false;
    const int* TL; const float* RSTD; bf16_t* HID;
    __device__ __forceinline__ bool operator()(f32x4 (&acc)[2][2][4][2], const pg8::Unit& u, int wr, int wc, int fr, int fq) const {
        const int cl = 128 * u.pn + wc * 32 + 8 * fq;
#pragma unroll
        for (int ai = 0; ai < 2; ++ai)
#pragma unroll
            for (int m = 0; m < 4; ++m) { const int rl = ai * 128 + wr * 64 + m * 16 + fr;
                if (rl < u.rows) { const float rs = RSTD[TL[u.aux * CAP + 256 * u.pm + rl] >> 1]; float v[8];
#pragma unroll
                    for (int j = 0; j < 4; ++j) { const float a0 = acc[ai][0][m][0][j] * rs, b0 = acc[ai][1][m][0][j] * rs, a1 = acc[ai][0][m][1][j] * rs, b1 = acc[ai][1][m][1][j] * rs;
                        v[j] = a0 * sigm(a0) * b0; v[4 + j] = a1 * sigm(a1) * b1; }
                    u32x4 w; w.x = cvt_pk_bf16(v[0], v[1]); w.y = cvt_pk_bf16(v[2], v[3]); w.z = cvt_pk_bf16(v[4], v[5]); w.w = cvt_pk_bf16(v[6], v[7]);
                    *(u32x4*)(HID + (size_t)(u.base + rl) * FF + cl) = w; } }
        return true;
    }
};
struct Moe2Sched {
    static constexpr bool GATHER = false, HALFABLE = true;
    MoeOrder mo; const bf16_t* HID; const bf16_t* W2;
    __device__ __forceinline__ bool next(int i, pg8::Unit& u) const { return mo.next(i, u); }
    __device__ __forceinline__ int kdim(const pg8::Unit&) const { return FF; }
    __device__ __forceinline__ const char* a_base(const pg8::Unit& u) const { return (const char*)HID + (size_t)u.base * FF * 2; }
    __device__ __forceinline__ const char* b_base(const pg8::Unit& u) const { return (const char*)W2 + ((size_t)u.aux * D + (size_t)u.pn * 256) * FF * 2; }
};
struct EpiMoe2 {         static constexpr bool STORES16 = false;
    bf16_t* YC;
    __device__ __forceinline__ bool operator()(f32x4 (&acc)[2][2][4][2], const pg8::Unit& u, int wr, int wc, int fr, int fq) const {
        const int col0 = u.pn * 256 + wc * 32 + 8 * fq;
#pragma unroll
        for (int ai = 0; ai < 2; ++ai)
#pragma unroll
            for (int m = 0; m < 4; ++m) { const int rl = ai * 128 + wr * 64 + m * 16 + fr;
                if (rl < u.rows) { bf16_t* dst = YC + (size_t)(u.base + rl) * D + col0;
#pragma unroll
                    for (int bj = 0; bj < 2; ++bj) { u32x4 w; w.x = cvt_pk_bf16(acc[ai][bj][m][0][0], acc[ai][bj][m][0][1]); w.y = cvt_pk_bf16(acc[ai][bj][m][0][2], acc[ai][bj][m][0][3]);
                        w.z = cvt_pk_bf16(acc[ai][bj][m][1][0], acc[ai][bj][m][1][1]); w.w = cvt_pk_bf16(acc[ai][bj][m][1][2], acc[ai][bj][m][1][3]);
                        *(u32x4*)(dst + bj * 128) = w; } } }
        return true;
    }
};

template <bool DRY> __device__ __forceinline__ void p10_final(Frame& F) {
    LAS int* RO = (LAS int*)(F.lds + MISC_OFF + 256) + 40; LAS int* CN = RO + 40;
    if (F.tid < NE) { int n = (int)__hip_atomic_load(F.ctl + CW_CNT + 64 * F.tid, __ATOMIC_RELAXED, __HIP_MEMORY_SCOPE_AGENT); CN[F.tid] = n > CAP ? CAP : n; }
    __syncthreads();
    if (F.tid == 0) { int ro = 0; for (int e = 0; e < NE; ++e) { RO[e] = ro; ro += CN[e]; } }
    __syncthreads();
    const int gw = F.vcu * 8 + F.wave, NGW = F.G * 8; const bf16_t* YC = WSP(bf16_t, WS_YS); const bf16_t* HM = WSP(bf16_t, WS_HM);
    f32x4 gg[8];
#pragma unroll
    for (int j = 0; j < 8; ++j) gg[j] = ((const f32x4*)F.in[16])[F.lane + 64 * j];
    const int* SP = WSP(int, WS_SP); const float* SW = WSP(float, WS_SW);
    for (int m = gw; m < T; m += NGW) {
        const int s0 = SP[2 * m], s1 = SP[2 * m + 1]; const float w0 = SW[2 * m], w1 = SW[2 * m + 1];
        const int r0 = RO[(s0 >> 16) & 31] + (s0 & 0xffff), r1 = RO[(s1 >> 16) & 31] + (s1 & 0xffff);
        const f32x4* xr = (const f32x4*)(F.in[0] + (size_t)m * D) + F.lane; const u32x2* hm = (const u32x2*)(HM + (size_t)m * D) + F.lane;
        const u32x2* y0 = (const u32x2*)(YC + (size_t)(r0 & 16383) * D) + F.lane; const u32x2* y1 = (const u32x2*)(YC + (size_t)(r1 & 16383) * D) + F.lane;
        f32x4 v[8]; float s = 0.f;
#pragma unroll
        for (int j = 0; j < 8; ++j) { v[j] = xr[64 * j]; const u32x2 h = hm[64 * j], a = y0[64 * j], b = y1[64 * j];
            v[j].x = ((v[j].x + bf_lo(h.x)) + w0 * bf_lo(a.x)) + w1 * bf_lo(b.x); v[j].y = ((v[j].y + bf_hi(h.x)) + w0 * bf_hi(a.x)) + w1 * bf_hi(b.x);
            v[j].z = ((v[j].z + bf_lo(h.y)) + w0 * bf_lo(a.y)) + w1 * bf_lo(b.y); v[j].w = ((v[j].w + bf_hi(h.y)) + w0 * bf_hi(a.y)) + w1 * bf_hi(b.y);
            s += (v[j].x * v[j].x + v[j].y * v[j].y) + (v[j].z * v[j].z + v[j].w * v[j].w); }
        const float rstd = __builtin_amdgcn_rsqf(wave_sum(s) * (1.f / D) + EPS);
        f32x4* orow = (DRY ? (f32x4*)(WSP(float, WS_W13) + (size_t)m * D) : (f32x4*)(F.out + (size_t)m * D)) + F.lane;
#pragma unroll
        for (int j = 0; j < 8; ++j) orow[64 * j] = v[j] * rstd * gg[j];
    }
}

__device__ __forceinline__ void ph0(Frame& F, int) { p0_prologue(F); __syncthreads(); }
__device__ __forceinline__ void ph1(Frame& F, int pass) {
    const int bx = (int)blockIdx.x, grp = bx >> 3; const bool split = (F.G == 256);
    const bool conv_only = split && (grp % 4 == 2) && (grp < 28);
    const int nbelow = grp < 2 ? 0 : ((grp - 2) / 4 + 1 < 7 ? (grp - 2) / 4 + ((grp - 2) % 4 ? 1 : 0) : 7);
    dense_units(F, T, NIN, split ? 200 : F.G, split ? (conv_only ? -1 : bx - 8 * nbelow) : bx);
    DenseSched S; S.A = WSP(bf16_t, WS_XN); S.Bt = WSP(bf16_t, WS_WIN); S.K = D; S.so.UD = (LAS int*)(F.lds + MISC_OFF + 1024);
    EpiInProj E{F.ws, F.in[3], F.in[4]};
    pg8::gemm_phase(F.lds, S, E);
    if (pass) p1_queue(F, 1 << 30);
}
__device__ __forceinline__ void ph2(Frame& F, int) {
    attn_phase<true>(F);
    { HgTile t; if (F.vcu < BH * NCH) hg_load<false>(F, F.vcu, t);
      for (int u = F.vcu; u < BH * NCH; u += F.G) hgrn_local_unit(F, u, t, u + F.G); }
}
__device__ __forceinline__ void ph3(Frame& F, int pass) {
    if (pass) hgrn_scan<false>(F); else hgrn_scan<true>(F);
    attn_phase<false>(F);
}
__device__ __forceinline__ void ph4(Frame& F, int) { HgTile t; if (F.vcu < BH * NCH) hg_load<true>(F, F.vcu, t);
    for (int u = F.vcu; u < BH * NCH; u += F.G) hgrn_out_unit(F, u, t, u + F.G); }
__device__ __forceinline__ void ph5(Frame& F, int) {
    dense_units(F, T, D, F.G, (int)blockIdx.x);
    MergedSched S; S.OA = WSP(bf16_t, WS_OA); S.WA = WSP(bf16_t, WS_WA); S.OB = WSP(bf16_t, WS_OB); S.WB = WSP(bf16_t, WS_WB); S.so.UD = (LAS int*)(F.lds + MISC_OFF + 1024);
    EpiMerged E{WSP(bf16_t, WS_GA), WSP(bf16_t, WS_GBT), WSP(bf16_t, WS_MERGED)};
    pg8::gemm_phase(F.lds, S, E);
}
__device__ __forceinline__ void ph6(Frame& F, int) {
    dense_units(F, T, D, F.G, (int)blockIdx.x);
    DenseSched S; S.A = WSP(bf16_t, WS_MERGED); S.Bt = WSP(bf16_t, WS_WOUT); S.K = D; S.so.UD = (LAS int*)(F.lds + MISC_OFF + 1024);
    EpiResid E{WSP(bf16_t, WS_HM)};
    pg8::gemm_phase(F.lds, S, E);
}
__device__ __forceinline__ void ph7(Frame& F, int pass) { if (pass) p7_router<false>(F); else p7_router<true>(F); }
__device__ __forceinline__ void ph8(Frame& F, int pass) {
    moe_tables<4>(F);
    LAS int* TP = (LAS int*)(F.lds + MISC_OFF + 256);
    Moe1Sched S; S.mo.UL = TP + 120; S.HN = WSP(bf16_t, WS_XN); S.W13 = WSP(bf16_t, WS_W13); S.TL = WSP(int, WS_TOKL);
    EpiMoe1 E{WSP(int, WS_TOKL), WSP(float, WS_RSTD), WSP(bf16_t, WS_HID)};
    pg8::gemm_phase(F.lds, S, E);
    if (pass) { const int nu = TP[NE] * 4, rem = nu % F.G;
        if (rem == 0) p8_filler(F, F.vcu, F.G); else if (F.vcu >= rem) p8_filler(F, F.vcu - rem, F.G - rem); }
}
__device__ __forceinline__ void ph9(Frame& F, int) {
    moe_tables<8>(F);
    LAS int* TP = (LAS int*)(F.lds + MISC_OFF + 256);
    Moe2Sched S; S.mo.UL = TP + 120; S.HID = WSP(bf16_t, WS_HID); S.W2 = (const bf16_t*)F.out;
    EpiMoe2 E{WSP(bf16_t, WS_YS)};
    pg8::gemm_phase(F.lds, S, E);
}
__device__ __forceinline__ void ph10(Frame& F, int pass) { if (pass) p10_final<false>(F); else p10_final<true>(F); }

constexpr int N_PHASES = 11;
struct Args { const float* in[17]; float* out; unsigned char* ws; int ph_lo, ph_hi; };
__global__ void __launch_bounds__(512, 2) fwd_kernel(Args args) {
    extern __shared__ __attribute__((aligned(16))) unsigned char lds_raw[];
    Frame F;
    F.lds = (LAS unsigned char*)lds_raw;
    F.tid = threadIdx.x; F.lane = F.tid & 63; F.wave = __builtin_amdgcn_readfirstlane(F.tid >> 6);
    F.G = gridDim.x; { const int bx = blockIdx.x; F.vcu = (F.G % 8 == 0) ? (bx % 8) * (F.G / 8) + bx / 8 : bx; }
    F.ws = args.ws; F.ctl = (unsigned*)(args.ws + WS_CTL); F.out = args.out;
#pragma unroll
    for (int i = 0; i < 17; ++i) F.in[i] = args.in[i];
    volatile LAS unsigned* MISC = (volatile LAS unsigned*)(F.lds + MISC_OFF);
    if (F.tid < 64) MISC[F.tid] = 0u;
    __syncthreads();
#if MK_PER_PHASE
#define GRID_BAR() do { } while (0)
#else
    XcdBarrier bar = xcd_barrier_post(F.ctl + CW_BAR, MISC + 8);
#define GRID_BAR() xcd_barrier(bar)
#endif
    const int lo = args.ph_lo, hi = args.ph_hi;
#define IN(k) (lo <= (k) && (k) < hi)
#define SEAM(k) do { if (IN(k) && IN((k) + 1)) GRID_BAR(); } while (0)
#define RUN(k, f) do { if (IN(k)) { if (PROBE_REPEAT == (k)) { f(F, 0); if ((k) == 7) { GRID_BAR(); } } f(F, 1); } } while (0)

    RUN(0, ph0);  SEAM(0);
    if (PROBE_REPEAT == 20) { for (int xb = 0; xb < 10; ++xb) GRID_BAR(); }
    RUN(1, ph1);  SEAM(1);
    RUN(2, ph2);  SEAM(2);
    RUN(3, ph3);  SEAM(3);
    RUN(4, ph4);  SEAM(4);
    RUN(5, ph5);  SEAM(5);
    RUN(6, ph6);  SEAM(6);
    RUN(7, ph7);  SEAM(7);
    RUN(8, ph8);  SEAM(8);
    RUN(9, ph9);  SEAM(9);
    RUN(10, ph10);
#undef IN
#undef SEAM
}

extern "C" void kernel_launch(void* const* d_in, const int* in_sizes, int n_in, void* d_out, int out_size, void* d_ws, size_t ws_size, hipStream_t stream) {
    static int grid = 0;
    if (grid == 0) {
        if (n_in != 17 || out_size != T * D || ws_size < WS_END) { fprintf(stderr, "kernel_launch: unexpected shapes (n_in %d, out %d, ws %zu < %zu)\n", n_in, out_size, ws_size, (size_t)WS_END); grid = -1; return; }
        int dev = 0, cus = 0, per_cu = 0;
        if (hipGetDevice(&dev) != hipSuccess || hipDeviceGetAttribute(&cus, hipDeviceAttributeMultiprocessorCount, dev) != hipSuccess) { grid = -1; return; }
        if (hipFuncSetAttribute((const void*)fwd_kernel, hipFuncAttributeMaxDynamicSharedMemorySize, LDS_BYTES) != hipSuccess) { fprintf(stderr, "kernel_launch: hipFuncSetAttribute failed\n"); grid = -1; return; }
        if (hipOccupancyMaxActiveBlocksPerMultiprocessor(&per_cu, (const void*)fwd_kernel, 512, LDS_BYTES) != hipSuccess || per_cu < 1) { fprintf(stderr, "kernel_launch: occupancy query says %d blocks per CU\n", per_cu); }
        (void)hipGetLastError();
        grid = cus;
    }
    if (grid < 0) return;
    (void)in_sizes;
    if (hipMemsetAsync((char*)d_ws + WS_CTL, 0, CTL_ZERO_BYTES, stream) != hipSuccess) return;
    Args a{};
    for (int i = 0; i < 17; ++i) a.in[i] = (const float*)d_in[i];
    a.out = (float*)d_out; a.ws = (unsigned char*)d_ws;
#if MK_PER_PHASE
    for (int p = 0; p < N_PHASES; ++p) { a.ph_lo = p; a.ph_hi = p + 1; hipLaunchKernelGGL(fwd_kernel, dim3(grid), dim3(512), LDS_BYTES, stream, a); }
#else
    a.ph_lo = 0; a.ph_hi = N_PHASES; hipLaunchKernelGGL(fwd_kernel, dim3(grid), dim3(512), LDS_BYTES, stream, a);
#endif
}
```
